# Optimizing an MI355X kernel written in HIP

```python
import jax, jax.numpy as jnp
from jax import lax
import numpy as np

D_MODEL = 1024
BATCH = 2
SEQ = 8192
DEPTH = 4

HEAD_DIM = 64
PLE_DIM = 256
GRID_W = 64
ROPE_THETA = 10000.0
RMS_EPS = 1e-6
D_FF = 2816
A_HEADS = 12
A_KV_HEADS = 4
A_GROUP = A_HEADS // A_KV_HEADS
A_RADIUS = 128
B_PAIRS = ((128, 1), (512, 4), (2048, 16))
B_SLOTS = 4
B_HEADS = B_SLOTS * len(B_PAIRS)
C_HEADS = D_MODEL // HEAD_DIM
NA_KH = 8
NA_KW = 16

A_Q = A_HEADS * HEAD_DIM
A_KV = A_KV_HEADS * HEAD_DIM
B_W = B_HEADS * HEAD_DIM
AB_IN = A_Q + 2 * A_KV + 3 * B_W
AB_OUT = A_Q + B_SLOTS * HEAD_DIM
C_IN = 3 * C_HEADS * HEAD_DIM
C_OUT = C_HEADS * HEAD_DIM
N_EVEN = (DEPTH + 1) // 2
N_ODD = DEPTH // 2
NEG_INF = -1e30

kernel_name = 'hybrid_banded_dilated_neighbourhood_encoder'


def rmsnorm(x, g):
    xf = x.astype(jnp.float32)
    y = xf * lax.rsqrt(jnp.mean(xf * xf, axis=-1, keepdims=True) + RMS_EPS)
    return (y * g.astype(jnp.float32)).astype(x.dtype)


def swiglu(x, w_gate, w_up, w_down):
    return (jax.nn.silu(x @ w_gate) * (x @ w_up)) @ w_down


def rope(x, pos):
    half = x.shape[-1] // 2
    inv = ROPE_THETA ** (-jnp.arange(half, dtype=jnp.float32) / half)
    ang = pos.astype(jnp.float32)[:, None] * inv[None, :]
    cos = jnp.cos(ang)[None, :, None, :]
    sin = jnp.sin(ang)[None, :, None, :]
    xf = x.astype(jnp.float32)
    x1, x2 = xf[..., :half], xf[..., half:]
    return jnp.concatenate([x1 * cos - x2 * sin, x2 * cos + x1 * sin], axis=-1).astype(x.dtype)


def banded_attention(q, k, v, radius, sink=None):
    n, L, hk, g, dh = q.shape
    bs = radius
    nb = -(-L // bs)
    lp = nb * bs
    q = jnp.pad(q, ((0, 0), (0, lp - L), (0, 0), (0, 0), (0, 0)))
    kv_pad = ((0, 0), (bs, lp - L + bs), (0, 0), (0, 0))
    k = jnp.pad(k, kv_pad).reshape(n, nb + 2, bs, hk, dh)
    v = jnp.pad(v, kv_pad).reshape(n, nb + 2, bs, hk, dh)
    kw = jnp.concatenate([k[:, :-2], k[:, 1:-1], k[:, 2:]], axis=2)
    vw = jnp.concatenate([v[:, :-2], v[:, 1:-1], v[:, 2:]], axis=2)
    qb = q.reshape(n, nb, bs, hk, g, dh)
    qpos = jnp.arange(lp).reshape(nb, bs)
    kpos = (jnp.arange(nb)[:, None] - 1) * bs + jnp.arange(3 * bs)[None, :]
    mask = (jnp.abs(qpos[:, :, None] - kpos[:, None, :]) <= radius) & ((kpos >= 0) & (kpos < L))[:, None, :]
    s = jnp.einsum('nbqhgd,nbkhd->nbhgqk', qb, kw).astype(jnp.float32) * (dh ** -0.5)
    s = jnp.where(mask[None, :, None, None], s, NEG_INF)
    m = jnp.max(s, axis=-1)
    if sink is not None:
        m = jnp.maximum(m, sink[:, :, None])
    e = jnp.exp(s - m[..., None])
    den = jnp.sum(e, axis=-1)
    if sink is not None:
        den = den + jnp.exp(sink[:, :, None] - m)
    pr = (e / den[..., None]).astype(v.dtype)
    o = jnp.einsum('nbhgqk,nbkhd->nbqhgd', pr, vw).reshape(n, lp, hk, g, dh)[:, :L]
    lse = (m + jnp.log(den)).transpose(0, 1, 4, 2, 3).reshape(n, lp, hk, g)[:, :L]
    return o, lse


def dilated_attention(q, k, v):
    bsz, s, _, dh = q.shape
    outs, lses = [], []
    for gi, (window, dil) in enumerate(B_PAIRS):
        lo = gi * B_SLOTS
        sub = s // dil

        def to_res(t):
            t = t[:, :, lo:lo + B_SLOTS]
            return t.reshape(bsz, sub, dil, B_SLOTS, dh).transpose(0, 2, 1, 3, 4).reshape(bsz * dil, sub, B_SLOTS, dh)

        o, lse = banded_attention(to_res(q)[:, :, :, None], to_res(k), to_res(v), window // (2 * dil))
        outs.append(o[:, :, :, 0].reshape(bsz, dil, sub, B_SLOTS, dh).transpose(0, 2, 1, 3, 4).reshape(bsz, s, B_SLOTS, dh))
        lses.append(lse[..., 0].reshape(bsz, dil, sub, B_SLOTS).transpose(0, 2, 1, 3).reshape(bsz, s, B_SLOTS))
    wts = jax.nn.softmax(jnp.stack(lses, axis=0), axis=0)
    out = jnp.einsum('gbsh,gbshd->bshd', wts, jnp.stack(outs, axis=0).astype(jnp.float32))
    return out.astype(q.dtype)


def neighbourhood_attention(q, k, v, rpb):
    bsz, s, nh, dh = q.shape
    rows = s // GRID_W
    kh = min(NA_KH, rows)
    kw = NA_KW
    qg = q.reshape(bsz, rows, GRID_W, nh, dh)
    kg = k.reshape(bsz, rows, GRID_W, nh, dh)
    vg = v.reshape(bsz, rows, GRID_W, nh, dh)
    cols = jnp.arange(GRID_W)
    col_start = jnp.clip(cols - kw // 2, 0, GRID_W - kw)
    col_idx = col_start[:, None] + jnp.arange(kw)[None, :]
    dc = col_idx - cols[:, None] + (NA_KW - 1)
    scale = dh ** -0.5

    def row_fn(i):
        rs = jnp.clip(i - kh // 2, 0, rows - kh)
        k_win = lax.dynamic_slice_in_dim(kg, rs, kh, axis=1)[:, :, col_idx]
        v_win = lax.dynamic_slice_in_dim(vg, rs, kh, axis=1)[:, :, col_idx]
        q_row = lax.dynamic_index_in_dim(qg, i, axis=1, keepdims=False)
        sc = jnp.einsum('bjhd,bajkhd->bhjak', q_row, k_win).astype(jnp.float32) * scale
        dr = rs + jnp.arange(kh) - i + (NA_KH - 1)
        bias = rpb[:, dr][:, :, dc].transpose(0, 2, 1, 3).astype(jnp.float32)
        sc = (sc + bias[None]).reshape(bsz, nh, GRID_W, kh * kw)
        pr = jax.nn.softmax(sc, axis=-1).reshape(bsz, nh, GRID_W, kh, kw).astype(v.dtype)
        return jnp.einsum('bhjak,bajkhd->bjhd', pr, v_win)

    o = lax.map(row_fn, jnp.arange(rows))
    return o.transpose(1, 0, 2, 3, 4).reshape(bsz, s, nh, dh)


def ab_mixer(xn, w_in, sink, w_out, pos):
    bsz, s, _ = xn.shape
    splits = [A_Q, A_Q + A_KV, A_Q + 2 * A_KV, A_Q + 2 * A_KV + B_W, A_Q + 2 * A_KV + 2 * B_W]
    qa, ka, va, qb, kb, vb = jnp.split(xn @ w_in, splits, axis=-1)
    qa = rope(qa.reshape(bsz, s, A_HEADS, HEAD_DIM), pos).reshape(bsz, s, A_KV_HEADS, A_GROUP, HEAD_DIM)
    ka = rope(ka.reshape(bsz, s, A_KV_HEADS, HEAD_DIM), pos)
    va = va.reshape(bsz, s, A_KV_HEADS, HEAD_DIM)
    oa, _ = banded_attention(qa, ka, va, A_RADIUS, sink.astype(jnp.float32).reshape(A_KV_HEADS, A_GROUP))
    shp = (bsz, s, B_HEADS, HEAD_DIM)
    ob = dilated_attention(rope(qb.reshape(shp), pos), rope(kb.reshape(shp), pos), vb.reshape(shp))
    mixed = jnp.concatenate([oa.reshape(bsz, s, A_Q).astype(xn.dtype),
                             ob.reshape(bsz, s, B_SLOTS * HEAD_DIM).astype(xn.dtype)], axis=-1)
    return mixed @ w_out


def c_mixer(xn, w_in, rpb, w_out):
    bsz, s, _ = xn.shape
    q, k, v = jnp.split(xn @ w_in, 3, axis=-1)
    shp = (bsz, s, C_HEADS, HEAD_DIM)
    o = neighbourhood_attention(q.reshape(shp), k.reshape(shp), v.reshape(shp), rpb)
    return o.reshape(bsz, s, C_OUT) @ w_out


def setup_inputs(seed: int = 0) -> dict:
    key = jax.random.key(seed)
    ks = jax.random.split(key, 21)
    d = D_MODEL

    def nrm(k, shape, scale):
        return scale * jax.random.normal(k, shape, jnp.float32)

    def gain(k, shape):
        return 1.0 + 0.05 * jax.random.normal(k, shape, jnp.float32)

    return {
        'x': nrm(ks[0], (BATCH, SEQ, d), 1.0),
        'p': nrm(ks[1], (DEPTH, BATCH, SEQ, PLE_DIM), 1.0),
        'norm_ffn1': gain(ks[2], (DEPTH, d)),
        'ffn1_w_gate': nrm(ks[3], (DEPTH, d, D_FF), d ** -0.5),
        'ffn1_w_up': nrm(ks[4], (DEPTH, d, D_FF), d ** -0.5),
        'ffn1_w_down': nrm(ks[5], (DEPTH, D_FF, d), D_FF ** -0.5),
        'norm_mix': gain(ks[6], (DEPTH, d)),
        'w_in_ab': nrm(ks[7], (N_EVEN, d, AB_IN), d ** -0.5),
        'sink_a': nrm(ks[8], (N_EVEN, A_HEADS), 0.5),
        'w_out_ab': nrm(ks[9], (N_EVEN, AB_OUT, d), AB_OUT ** -0.5),
        'w_in_c': nrm(ks[10], (N_ODD, d, C_IN), d ** -0.5),
        'rpb_c': nrm(ks[11], (N_ODD, C_HEADS, 2 * NA_KH - 1, 2 * NA_KW - 1), 0.5),
        'w_out_c': nrm(ks[12], (N_ODD, C_OUT, d), C_OUT ** -0.5),
        'norm_ffn2': gain(ks[13], (DEPTH, d)),
        'ffn2_w_gate': nrm(ks[14], (DEPTH, d, D_FF), d ** -0.5),
        'ffn2_w_up': nrm(ks[15], (DEPTH, d, D_FF), d ** -0.5),
        'ffn2_w_down': nrm(ks[16], (DEPTH, D_FF, d), D_FF ** -0.5),
        'norm_ple': gain(ks[17], (DEPTH, d)),
        'w_ple_gate': nrm(ks[18], (DEPTH, d, d), d ** -0.5),
        'w_ple_proj': nrm(ks[19], (DEPTH, PLE_DIM, d), PLE_DIM ** -0.5),
        'norm_final': gain(ks[20], (d,)),
    }


def reference(x, p, norm_ffn1, ffn1_w_gate, ffn1_w_up, ffn1_w_down, norm_mix, w_in_ab, sink_a,
              w_out_ab, w_in_c, rpb_c, w_out_c, norm_ffn2, ffn2_w_gate, ffn2_w_up, ffn2_w_down,
              norm_ple, w_ple_gate, w_ple_proj, norm_final):
    s = x.shape[1]
    pos = jnp.arange(s, dtype=jnp.int32)
    h = x
    for i in range(DEPTH):
        h = h + 0.5 * swiglu(rmsnorm(h, norm_ffn1[i]), ffn1_w_gate[i], ffn1_w_up[i], ffn1_w_down[i])
        hn = rmsnorm(h, norm_mix[i])
        j = i // 2
        if i % 2 == 0:
            h = h + ab_mixer(hn, w_in_ab[j], sink_a[j], w_out_ab[j], pos)
        else:
            h = h + c_mixer(hn, w_in_c[j], rpb_c[j], w_out_c[j])
        h = h + 0.5 * swiglu(rmsnorm(h, norm_ffn2[i]), ffn2_w_gate[i], ffn2_w_up[i], ffn2_w_down[i])
        gate = jax.nn.sigmoid(rmsnorm(h, norm_ple[i]) @ w_ple_gate[i])
        h = h + gate * (p[i] @ w_ple_proj[i])
    return rmsnorm(h, norm_final)
```

```cpp
#include <hip/hip_runtime.h>
#include <hip/hip_cooperative_groups.h>
#include <cstdio>
#include <cstdint>
namespace cg = cooperative_groups;
namespace pg8 {
#define PG8_LAS __attribute__((address_space(3)))
typedef unsigned short bf16_t;
typedef short bf16x8 __attribute__((ext_vector_type(8)));
typedef float f32x4 __attribute__((ext_vector_type(4)));
typedef unsigned u32x4 __attribute__((ext_vector_type(4)));
constexpr int BM = 256, BK = 64, HALF = 128, HTB = HALF * BK * 2  , STAGE_BYTES = 8 * HTB, NXCD = 8, WGM = 8;

__host__ __device__ __forceinline__ int lds_byte(int r, int c) { const int st = (r >> 4) * 2 + (c >> 5), rr = r & 15, cc = c & 31, ob = rr * 64 + cc * 2; return st * 1024 + (ob ^ (((ob >> 9) & 1) << 5)); }
__host__ __device__ __forceinline__ void stage_rc(int b, int& R, int& C) { const int st = b / 1024, sb = b % 1024, swz = sb ^ (((sb >> 9) & 1) << 5); R = (st >> 1) * 16 + swz / 64; C = (st & 1) * 32 + (swz % 64) / 2; }
__host__ __device__ __forceinline__ int perm32(int rho) { const int n = rho >> 4, i = rho & 15; return 8 * (i >> 2) + 4 * n + (i & 3); }

struct Unit { int pm, pn; };
struct Gemm { const bf16_t* A; const bf16_t* Bt; int M, N, K; };

struct StaticOrder {
    int nM, nN, nwg, G, c;
    __host__ __device__ void init(int M, int N, int G_, int c_) { nM = M / BM; nN = N / BM; nwg = nM * nN; G = G_; c = c_; }
    __host__ __device__ bool next(int i, Unit& u) const {
        const long L = (long)i * G + c; if (L >= nwg) return false;
        int wgid = (int)L; { const int q = nwg / NXCD, r = nwg % NXCD, xcd = wgid % NXCD, off = wgid / NXCD; wgid = (xcd < r ? xcd * (q + 1) : r * (q + 1) + (xcd - r) * q) + off; }
        const int nig = WGM * nN, gid = wgid / nig, fm = gid * WGM, gsz = (nM - fm) < WGM ? (nM - fm) : WGM;
        u.pm = fm + ((wgid % nig) % gsz); u.pn = (wgid % nig) / gsz; return true;
    }
    __device__ __forceinline__ void a_ready(const Unit&) const {}
    __device__ __forceinline__ void done(const Unit&) const {}
};


template <class Epi, class Sched, bool ALIGN_EPI = false, bool SP2 = false>
__device__ __forceinline__ void gemm_phase(PG8_LAS unsigned char* lds, const Gemm g, const Sched& S, const Epi& E, int tid_in) {
    int tid_o = tid_in; asm volatile("" : "+v"(tid_o));
    const int tid = tid_o, wid = __builtin_amdgcn_readfirstlane(tid >> 6), lane = tid & 63, wr = wid >> 2, wc = wid & 3, fr = lane & 15, fq = lane >> 4;
    const int K = g.K, nt = K / BK;
    unsigned voffA[2], voffB[2];
#pragma unroll
    for (int i = 0; i < 2; ++i) { int R, C; stage_rc(tid * 16 + i * 8192, R, C); const int Rb = Epi::PERM ? ((R & ~31) + perm32(R & 31)) : R;
        voffA[i] = (unsigned)(R * K + C) * 2u; voffB[i] = (unsigned)(Rb * K + C) * 2u; }
    const size_t kstep = (size_t)(BK * 2);
    const size_t hstep = (size_t)HALF * K * 2;
    const size_t tstep = 2 * hstep;
    const unsigned ldsw = (unsigned)wid * 1024u;
    const int aoff = lds_byte(wr * 64 + fr, fq * 8), boff = lds_byte(wc * 32 + fr, fq * 8);
#define PG8_SA(b, h) (((b) * 2 + (h)) * HTB)
#define PG8_SB(b, h) ((4 + (b) * 2 + (h)) * HTB)
#define PG8_STAGE(bufoff, gbase, voff) do { _Pragma("unroll") for (int _i = 0; _i < 2; ++_i) \
        __builtin_amdgcn_global_load_lds((const unsigned*)((const char*)(gbase) + (voff)[_i]), (PG8_LAS unsigned*)(lds + (bufoff) + ldsw + _i * 8192), 16, 0, 0); } while (0)
#define PG8_LDA(dst, b, h) do { _Pragma("unroll") for (int m = 0; m < 4; ++m) _Pragma("unroll") for (int k = 0; k < 2; ++k) dst[m][k] = *(const PG8_LAS bf16x8*)(lds + PG8_SA(b, h) + aoff + m * 2048 + k * 1024); } while (0)
#define PG8_LDB(dst, b, h) do { _Pragma("unroll") for (int n = 0; n < 2; ++n) _Pragma("unroll") for (int k = 0; k < 2; ++k) dst[n][k] = *(const PG8_LAS bf16x8*)(lds + PG8_SB(b, h) + boff + n * 2048 + k * 1024); } while (0)
#define PG8_MMA(ai, bj, At, Bt) do { __builtin_amdgcn_s_setprio(1); _Pragma("unroll") for (int m = 0; m < 4; ++m) _Pragma("unroll") for (int n = 0; n < 2; ++n) _Pragma("unroll") for (int k = 0; k < 2; ++k) \
        acc[ai][bj][m][n] = __builtin_amdgcn_mfma_f32_16x16x32_bf16(Bt[n][k], At[m][k], acc[ai][bj][m][n], 0, 0, 0); __builtin_amdgcn_s_setprio(0); } while (0)
#define PG8_WAIT_V(n) asm volatile("s_waitcnt vmcnt(" #n ")" ::: "memory")
#define PG8_WAIT_L(n) asm volatile("s_waitcnt lgkmcnt(" #n ")" ::: "memory")
#define PG8_BAR __builtin_amdgcn_s_barrier()
#define PG8_SCHED __builtin_amdgcn_sched_barrier(0)
    Unit cur, nxt; int ui = 0;
    if (!S.next(0, cur)) return;
    f32x4 acc[2][2][4][2];
#pragma unroll
    for (int a = 0; a < 2; ++a)
#pragma unroll
        for (int b = 0; b < 2; ++b)
#pragma unroll
            for (int m = 0; m < 4; ++m)
#pragma unroll
                for (int n = 0; n < 2; ++n) acc[a][b][m][n] = (f32x4){0.f, 0.f, 0.f, 0.f};
    bf16x8 At[4][2], B0[2][2], B1[2][2];
    const char* cA = (const char*)g.A + (size_t)cur.pm * tstep; const char* cB = (const char*)g.Bt + (size_t)cur.pn * tstep;
    S.a_ready(cur);
    if constexpr (SP2) {
        PG8_STAGE(PG8_SB(0, 0), cB, voffB); PG8_STAGE(PG8_SB(0, 1), cB + hstep, voffB); PG8_STAGE(PG8_SA(0, 0), cA, voffA); PG8_STAGE(PG8_SA(0, 1), cA + hstep, voffA);
        if (wr == 1) PG8_BAR;
        PG8_WAIT_V(2); PG8_BAR;
        PG8_STAGE(PG8_SB(1, 0), cB + kstep, voffB); PG8_STAGE(PG8_SA(1, 0), cA + kstep, voffA); PG8_STAGE(PG8_SB(1, 1), cB + hstep + kstep, voffB);
        PG8_WAIT_V(6); PG8_BAR;
    } else {
        PG8_STAGE(PG8_SB(0, 0), cB, voffB); PG8_STAGE(PG8_SA(0, 0), cA, voffA); PG8_STAGE(PG8_SB(0, 1), cB + hstep, voffB); PG8_STAGE(PG8_SA(0, 1), cA + hstep, voffA);
        if (wr == 1) PG8_BAR;
        PG8_WAIT_V(4); PG8_BAR;
        PG8_STAGE(PG8_SB(1, 0), cB + kstep, voffB); PG8_STAGE(PG8_SA(1, 0), cA + kstep, voffA); PG8_STAGE(PG8_SB(1, 1), cB + hstep + kstep, voffB);
        PG8_WAIT_V(6); PG8_BAR;
    }
    for (;;) {
        const bool has_next = S.next(ui + 1, nxt);
        const char* nA = has_next ? (const char*)g.A + (size_t)nxt.pm * tstep : cA; const char* nB = has_next ? (const char*)g.Bt + (size_t)nxt.pn * tstep : cB;
        for (int t = 0; t < nt; t += 2) {
            const bool last = (t == nt - 2);
            const char* a1 = cA + (size_t)(t + 1) * kstep;
            const char* a2 = last ? nA : cA + (size_t)(t + 2) * kstep; const char* b2 = last ? nB : cB + (size_t)(t + 2) * kstep;
            const char* a3 = a2 + kstep; const char* b3 = b2 + kstep;
            if (last && has_next) S.a_ready(nxt);
            if constexpr (SP2) {
            PG8_LDB(B0, 0, 0); PG8_LDB(B1, 0, 1); PG8_SCHED; PG8_LDA(At, 0, 0); PG8_STAGE(PG8_SA(1, 1), a1 + hstep, voffA);
            PG8_WAIT_V(8); PG8_WAIT_L(0); PG8_BAR; PG8_MMA(0, 0, At, B0); PG8_MMA(0, 1, At, B1); PG8_BAR; PG8_SCHED;
            PG8_LDA(At, 0, 1); PG8_STAGE(PG8_SB(0, 0), b2, voffB); PG8_STAGE(PG8_SB(0, 1), b2 + hstep, voffB); PG8_STAGE(PG8_SA(0, 0), a2, voffA);
            PG8_WAIT_V(8); PG8_WAIT_L(0); PG8_BAR; PG8_MMA(1, 0, At, B0); PG8_MMA(1, 1, At, B1); PG8_BAR; PG8_SCHED;
            PG8_LDB(B0, 1, 0); PG8_LDB(B1, 1, 1); PG8_SCHED; PG8_LDA(At, 1, 0); PG8_STAGE(PG8_SA(0, 1), a2 + hstep, voffA);
            PG8_WAIT_V(8); PG8_WAIT_L(0); PG8_BAR; PG8_MMA(0, 0, At, B0); PG8_MMA(0, 1, At, B1); PG8_BAR; PG8_SCHED;
            PG8_LDA(At, 1, 1); PG8_STAGE(PG8_SB(1, 0), b3, voffB); PG8_STAGE(PG8_SB(1, 1), b3 + hstep, voffB); PG8_STAGE(PG8_SA(1, 0), a3, voffA);
            PG8_WAIT_V(8); PG8_WAIT_L(0); PG8_BAR; PG8_MMA(1, 0, At, B0); PG8_MMA(1, 1, At, B1); PG8_BAR; PG8_SCHED;
            } else {
            PG8_LDB(B0, 0, 0); PG8_SCHED; PG8_LDA(At, 0, 0); PG8_STAGE(PG8_SA(1, 1), a1 + hstep, voffA);
            PG8_WAIT_L(8); PG8_BAR; PG8_WAIT_L(0); PG8_MMA(0, 0, At, B0); PG8_BAR; PG8_SCHED;
            PG8_LDB(B1, 0, 1); PG8_STAGE(PG8_SB(0, 0), b2, voffB);
            PG8_BAR; PG8_WAIT_L(0); PG8_MMA(0, 1, At, B1); PG8_BAR;
            PG8_LDA(At, 0, 1); PG8_STAGE(PG8_SA(0, 0), a2, voffA);
            PG8_BAR; PG8_WAIT_L(0); PG8_MMA(1, 0, At, B0); PG8_BAR; PG8_SCHED;
            PG8_STAGE(PG8_SB(0, 1), b2 + hstep, voffB);
            PG8_WAIT_V(6); PG8_BAR; PG8_MMA(1, 1, At, B1); PG8_BAR;
            PG8_LDB(B0, 1, 0); PG8_SCHED; PG8_LDA(At, 1, 0); PG8_STAGE(PG8_SA(0, 1), a2 + hstep, voffA);
            PG8_WAIT_L(8); PG8_BAR; PG8_WAIT_L(0); PG8_MMA(0, 0, At, B0); PG8_BAR; PG8_SCHED;
            PG8_LDB(B1, 1, 1); PG8_STAGE(PG8_SB(1, 0), b3, voffB);
            PG8_BAR; PG8_WAIT_L(0); PG8_MMA(0, 1, At, B1); PG8_BAR;
            PG8_LDA(At, 1, 1); PG8_STAGE(PG8_SA(1, 0), a3, voffA);
            PG8_BAR; PG8_WAIT_L(0); PG8_MMA(1, 0, At, B0); PG8_BAR; PG8_SCHED;
            PG8_STAGE(PG8_SB(1, 1), b3 + hstep, voffB);
            PG8_WAIT_V(6); PG8_BAR; PG8_MMA(1, 1, At, B1); PG8_BAR;
            }
        }
        if constexpr (ALIGN_EPI) { if (wr == 0) PG8_BAR; }
        if constexpr (!Epi::AFTER_DRAIN) { E(acc, cur, wr, wc, fr, fq); S.done(cur); }
        if (!has_next) break;
#pragma unroll
        for (int a = 0; a < 2; ++a)
#pragma unroll
            for (int b = 0; b < 2; ++b)
#pragma unroll
                for (int m = 0; m < 4; ++m)
#pragma unroll
                    for (int n = 0; n < 2; ++n) acc[a][b][m][n] = (f32x4){0.f, 0.f, 0.f, 0.f};
        cur = nxt; cA = nA; cB = nB; ++ui;
        if constexpr (ALIGN_EPI) { if (wr == 1) PG8_BAR; }
    }
    PG8_WAIT_V(0);
    if constexpr (!ALIGN_EPI) { if (wr == 0) PG8_BAR; }
    PG8_BAR;
    if constexpr (Epi::AFTER_DRAIN) { E.fused(acc, cur, wr, wc, fr, fq, lds, wid, lane); S.done(cur); }
#undef PG8_SA
#undef PG8_SB
#undef PG8_STAGE
#undef PG8_LDA
#undef PG8_LDB
#undef PG8_MMA
#undef PG8_WAIT_V
#undef PG8_WAIT_L
#undef PG8_BAR
#undef PG8_SCHED
}
}

#define LAS __attribute__((address_space(3)))
typedef unsigned short bf16_t;
typedef short bf16x8 __attribute__((ext_vector_type(8)));
typedef short s16x4 __attribute__((ext_vector_type(4)));
typedef float f32x4 __attribute__((ext_vector_type(4)));
typedef float f32x16 __attribute__((ext_vector_type(16)));
typedef unsigned u32x4 __attribute__((ext_vector_type(4)));
typedef unsigned u32x2 __attribute__((ext_vector_type(2)));

#ifndef MK_COOP
#define MK_COOP 0
#endif

constexpr int NWAVES = 8;
constexpr int T = 16384, SEQ = 8192, D = 1024, FF = 2816, NGU = 5632, NAB = 3584, NC = 3072, PLE = 256, DEPTH = 4;
constexpr float EPS = 1e-6f;
constexpr float LOG2E = 1.4426950408889634f;
constexpr float SC2 = 0.125f * LOG2E;
constexpr float NEGINF = -__builtin_huge_valf();

constexpr size_t O_GU1 = 0, O_D1 = 5767168, O_GU2 = 8650752, O_D2 = 14417920, O_IN = 17301504, O_OUT = 20971520, O_PG = 22020096, O_PP = 23068672, LAYER_W = 23330816;
constexpr size_t MiB = 1u << 20;
constexpr size_t WS_SSQ = 1 * MiB, WS_COS = 3 * MiB, WS_SIN = 4 * MiB, WS_LSE = 5 * MiB, WS_W = 6 * MiB, WS_HB = 184 * MiB, WS_ACT = 216 * MiB,
                 WS_VT = 328 * MiB, WS_AO = 360 * MiB, WS_OBP = 392 * MiB, WS_PB = 416 * MiB, WS_END = 448 * MiB;
static_assert(WS_W + LAYER_W * 4 * 2 <= WS_HB, "weights fit");
constexpr int LDS_BYTES = 131072 + 1024;

__device__ __forceinline__ unsigned f2bf(float f) { unsigned u = __builtin_bit_cast(unsigned, f); return (u + 0x7fffu + ((u >> 16) & 1u)) >> 16; }
__device__ __forceinline__ unsigned pk2(float lo, float hi) {
    typedef float f2_t __attribute__((ext_vector_type(2))); typedef __bf16 b2_t __attribute__((ext_vector_type(2)));
    f2_t v = {lo, hi}; b2_t b = __builtin_convertvector(v, b2_t); return __builtin_bit_cast(unsigned, b);
}
__device__ __forceinline__ float bflo(unsigned w) { return __builtin_bit_cast(float, w << 16); }
__device__ __forceinline__ float bfhi(unsigned w) { return __builtin_bit_cast(float, w & 0xffff0000u); }
__device__ __forceinline__ float wave_sum(float v) {
#pragma unroll
    for (int o = 1; o < 64; o <<= 1) v += __shfl_xor(v, o);
    return v;
}
__device__ __forceinline__ float fexp2(float x) { return __builtin_amdgcn_exp2f(x); }
__device__ __forceinline__ float frcp(float x) { return __builtin_amdgcn_rcpf(x); }
__device__ __forceinline__ float sigmoidf_(float x) { return frcp(1.f + fexp2(-x * LOG2E)); }

using pg8::Unit;

struct EpiGateUp {
    static constexpr bool PERM = true, AFTER_DRAIN = false;
    bf16_t* O; const float* ssq;
    __device__ __forceinline__ void operator()(const f32x4 (&acc)[2][2][4][2], const Unit& u, int wr, int wc, int fr, int fq) const {
        const int row0 = u.pm * 256 + wr * 64 + fr;
#pragma unroll
        for (int ai = 0; ai < 2; ++ai)
#pragma unroll
            for (int m = 0; m < 4; ++m) {
                __builtin_amdgcn_sched_barrier(0); const int row = row0 + ai * 128 + m * 16;
                const float r = __builtin_amdgcn_rsqf(ssq[row] * (1.f / 1024.f) + EPS);
#pragma unroll
                for (int bj = 0; bj < 2; ++bj) {
                    const f32x4 g = acc[ai][bj][m][0] * r, up = acc[ai][bj][m][1] * r;
                    float v[4];
#pragma unroll
                    for (int i = 0; i < 4; ++i) v[i] = g[i] * sigmoidf_(g[i]) * up[i];
                    const int ff = u.pn * 128 + bj * 64 + wc * 16 + fq * 4;
                    u32x2 w; w.x = pk2(v[0], v[1]); w.y = pk2(v[2], v[3]);
                    *(u32x2*)(O + (size_t)row * FF + ff) = w;
                }
            }
    }
};

template <int MODE> struct EpiRes {
    static constexpr bool PERM = true, AFTER_DRAIN = false;
    float* h; bf16_t* hb; float* ssq_out; const float* ssq_in; const bf16_t* pp; float scale;
    __device__ __forceinline__ void operator()(const f32x4 (&acc)[2][2][4][2], const Unit& u, int wr, int wc, int fr, int fq) const {
        const int row0 = u.pm * 256 + wr * 64 + fr;
#pragma unroll
        for (int ai = 0; ai < 2; ++ai)
#pragma unroll
            for (int m = 0; m < 4; ++m) {
                __builtin_amdgcn_sched_barrier(0); const int row = row0 + ai * 128 + m * 16;
                float r = 0.f;
                if (MODE == 1) r = __builtin_amdgcn_rsqf(ssq_in[row] * (1.f / 1024.f) + EPS);
                float part = 0.f;
#pragma unroll
                for (int bj = 0; bj < 2; ++bj) {
                    const int col = u.pn * 256 + bj * 128 + wc * 32 + 8 * fq;
                    float* hp = h + (size_t)row * D + col;
                    f32x4 h0 = *(const f32x4*)hp, h1 = *(const f32x4*)(hp + 4);
                    const f32x4 a0 = acc[ai][bj][m][0], a1 = acc[ai][bj][m][1];
                    if (MODE == 0) { h0 += a0 * scale; h1 += a1 * scale; }
                    else {
                        const u32x4 pw = *(const u32x4*)(pp + (size_t)row * D + col);
                        h0[0] += sigmoidf_(a0[0] * r) * bflo(pw.x); h0[1] += sigmoidf_(a0[1] * r) * bfhi(pw.x);
                        h0[2] += sigmoidf_(a0[2] * r) * bflo(pw.y); h0[3] += sigmoidf_(a0[3] * r) * bfhi(pw.y);
                        h1[0] += sigmoidf_(a1[0] * r) * bflo(pw.z); h1[1] += sigmoidf_(a1[1] * r) * bfhi(pw.z);
                        h1[2] += sigmoidf_(a1[2] * r) * bflo(pw.w); h1[3] += sigmoidf_(a1[3] * r) * bfhi(pw.w);
                    }
                    *(f32x4*)hp = h0; *(f32x4*)(hp + 4) = h1;
                    u32x4 w; w.x = pk2(h0[0], h0[1]); w.y = pk2(h0[2], h0[3]); w.z = pk2(h1[0], h1[1]); w.w = pk2(h1[2], h1[3]);
                    *(u32x4*)(hb + (size_t)row * D + col) = w;
                    part += (h0[0] * h0[0] + h0[1] * h0[1]) + (h0[2] * h0[2] + h0[3] * h0[3]) + (h1[0] * h1[0] + h1[1] * h1[1]) + (h1[2] * h1[2] + h1[3] * h1[3]);
                }
                part += __shfl_xor(part, 16); part += __shfl_xor(part, 32);
                if (fq == 0) atomicAdd(ssq_out + row, part);
            }
    }
};

struct EpiPlain {
    static constexpr bool PERM = true, AFTER_DRAIN = false;
    bf16_t* O;
    __device__ __forceinline__ void operator()(const f32x4 (&acc)[2][2][4][2], const Unit& u, int wr, int wc, int fr, int fq) const {
        const int row0 = u.pm * 256 + wr * 64 + fr;
#pragma unroll
        for (int ai = 0; ai < 2; ++ai)
#pragma unroll
            for (int m = 0; m < 4; ++m) {
                __builtin_amdgcn_sched_barrier(0); const int row = row0 + ai * 128 + m * 16;
#pragma unroll
                for (int bj = 0; bj < 2; ++bj) {
                    const int col = u.pn * 256 + bj * 128 + wc * 32 + 8 * fq;
                    const f32x4 a0 = acc[ai][bj][m][0], a1 = acc[ai][bj][m][1];
                    u32x4 w; w.x = pk2(a0[0], a0[1]); w.y = pk2(a0[2], a0[3]); w.z = pk2(a1[0], a1[1]); w.w = pk2(a1[2], a1[3]);
                    *(u32x4*)(O + (size_t)row * D + col) = w;
                }
            }
    }
};

template <int AB> struct EpiQKV {
    static constexpr bool PERM = true, AFTER_DRAIN = false;
    bf16_t* qk; bf16_t* vT; const float* ssq; const float* ctab; const float* stab;
    __device__ __forceinline__ void operator()(const f32x4 (&acc)[2][2][4][2], const Unit& u, int wr, int wc, int fr, int fq) const {
        constexpr int LDQ = AB ? NAB : NC;
        const int pn = u.pn;
        int kind, vrow0 = 0, dsh = 0;
        if (AB) { if (pn == 4) { kind = 2; vrow0 = 0; } else if (pn >= 11) { kind = 2; vrow0 = 256 + (pn - 11) * 256; dsh = 2 * (pn - 11); } else kind = 0; }
        else { if (pn >= 8) { kind = 2; vrow0 = (pn - 8) * 256; } else kind = 1; }
        const int row0 = u.pm * 256 + wr * 64 + fr;
#pragma unroll
        for (int ai = 0; ai < 2; ++ai)
#pragma unroll
            for (int m = 0; m < 4; ++m) {
                __builtin_amdgcn_sched_barrier(0); const int row = row0 + ai * 128 + m * 16;
                const float r = __builtin_amdgcn_rsqf(ssq[row] * (1.f / 1024.f) + EPS);
                if (kind == 0) {
                    const int pos = row & (SEQ - 1), dd = 16 * (wc & 1) + 4 * fq;
                    const f32x4 c4 = *(const f32x4*)(ctab + pos * 32 + dd), s4 = *(const f32x4*)(stab + pos * 32 + dd);
#pragma unroll
                    for (int bj = 0; bj < 2; ++bj) {
                        const f32x4 x1 = acc[ai][bj][m][0] * r, x2 = acc[ai][bj][m][1] * r;
                        const f32x4 o1 = x1 * c4 - x2 * s4, o2 = x2 * c4 + x1 * s4;
                        bf16_t* op = qk + (size_t)row * LDQ + pn * 256 + bj * 128 + (wc >> 1) * 64 + dd;
                        u32x2 w1, w2; w1.x = pk2(o1[0], o1[1]); w1.y = pk2(o1[2], o1[3]); w2.x = pk2(o2[0], o2[1]); w2.y = pk2(o2[2], o2[3]);
                        *(u32x2*)op = w1; *(u32x2*)(op + 32) = w2;
                    }
                } else if (kind == 1) {
#pragma unroll
                    for (int bj = 0; bj < 2; ++bj) {
                        const f32x4 a0 = acc[ai][bj][m][0] * r, a1 = acc[ai][bj][m][1] * r;
                        u32x4 w; w.x = pk2(a0[0], a0[1]); w.y = pk2(a0[2], a0[3]); w.z = pk2(a1[0], a1[1]); w.w = pk2(a1[2], a1[3]);
                        *(u32x4*)(qk + (size_t)row * LDQ + pn * 256 + bj * 128 + wc * 32 + 8 * fq) = w;
                    }
                } else {
                    const int s = row & (SEQ - 1), b = row >> 13;
                    const int tidx = b * SEQ + (s & ((1 << dsh) - 1)) * (SEQ >> dsh) + (s >> dsh);
#pragma unroll
                    for (int bj = 0; bj < 2; ++bj)
#pragma unroll
                        for (int n = 0; n < 2; ++n)
#pragma unroll
                            for (int i = 0; i < 4; ++i) {
                                const int vr = vrow0 + bj * 128 + wc * 32 + 8 * fq + 4 * n + i;
                                vT[(size_t)vr * T + tidx] = (bf16_t)f2bf(acc[ai][bj][m][n][i] * r);
                            }
                }
            }
    }
};

#define MFMA32(a, b, c) __builtin_amdgcn_mfma_f32_32x32x16_bf16((a), (b), (c), 0, 0, 0)
__device__ __forceinline__ int crow(int reg, int h) { return (reg & 3) + 8 * (reg >> 2) + 4 * h; }
struct AttnSt { f32x16 o0, o1; float m, l; };

__device__ __forceinline__ void attn_init(AttnSt& st, float m0, float l0) {
#pragma unroll
    for (int i = 0; i < 16; ++i) { st.o0[i] = 0.f; st.o1[i] = 0.f; }
    st.m = m0; st.l = l0;
}
__device__ __forceinline__ void attn_tile(AttnSt& st, const bf16x8 (&qf)[4], const bf16_t* krow, const bf16_t* v0, int hh, const f32x16& bias) {
    bf16x8 kf[4];
#pragma unroll
    for (int s = 0; s < 4; ++s) kf[s] = *(const bf16x8*)(krow + 16 * s + 8 * hh);
    bf16x8 vf[2][2];
#pragma unroll
    for (int db = 0; db < 2; ++db)
#pragma unroll
        for (int s2 = 0; s2 < 2; ++s2) {
            const bf16_t* p = v0 + (size_t)db * 32 * T + 16 * s2 + 4 * hh;
            const s16x4 lo = *(const s16x4*)p, hi = *(const s16x4*)(p + 8);
            vf[db][s2] = (bf16x8){lo[0], lo[1], lo[2], lo[3], hi[0], hi[1], hi[2], hi[3]};
        }
    f32x16 x;
#pragma unroll
    for (int i = 0; i < 16; ++i) x[i] = 0.f;
#pragma unroll
    for (int s = 0; s < 4; ++s) x = MFMA32(kf[s], qf[s], x);
    float mx = NEGINF;
#pragma unroll
    for (int i = 0; i < 16; ++i) { x[i] = x[i] * SC2 + bias[i]; mx = fmaxf(mx, x[i]); }
    mx = fmaxf(mx, __shfl_xor(mx, 32));
    const float mn = fmaxf(st.m, mx);
    const float alpha = fexp2(st.m - mn);
    float ls = 0.f;
#pragma unroll
    for (int i = 0; i < 16; ++i) { x[i] = fexp2(x[i] - mn); ls += x[i]; }
    ls += __shfl_xor(ls, 32);
    st.l = st.l * alpha + ls; st.m = mn;
#pragma unroll
    for (int i = 0; i < 16; ++i) { st.o0[i] *= alpha; st.o1[i] *= alpha; }
    u32x4 p0, p1;
    p0.x = pk2(x[0], x[1]); p0.y = pk2(x[2], x[3]); p0.z = pk2(x[4], x[5]); p0.w = pk2(x[6], x[7]);
    p1.x = pk2(x[8], x[9]); p1.y = pk2(x[10], x[11]); p1.z = pk2(x[12], x[13]); p1.w = pk2(x[14], x[15]);
    const bf16x8 pf0 = __builtin_bit_cast(bf16x8, p0), pf1 = __builtin_bit_cast(bf16x8, p1);
    st.o0 = MFMA32(vf[0][0], pf0, st.o0); st.o0 = MFMA32(vf[0][1], pf1, st.o0);
    st.o1 = MFMA32(vf[1][0], pf0, st.o1); st.o1 = MFMA32(vf[1][1], pf1, st.o1);
}
__device__ __forceinline__ void attn_store(const AttnSt& st, bf16_t* orow, int hh) {
    const float inv = 1.f / st.l;
#pragma unroll
    for (int g = 0; g < 4; ++g) {
        u32x2 w0, w1;
        w0.x = pk2(st.o0[4 * g] * inv, st.o0[4 * g + 1] * inv); w0.y = pk2(st.o0[4 * g + 2] * inv, st.o0[4 * g + 3] * inv);
        w1.x = pk2(st.o1[4 * g] * inv, st.o1[4 * g + 1] * inv); w1.y = pk2(st.o1[4 * g + 2] * inv, st.o1[4 * g + 3] * inv);
        *(u32x2*)(orow + 8 * g + 4 * hh) = w0; *(u32x2*)(orow + 32 + 8 * g + 4 * hh) = w1;
    }
}
__device__ __forceinline__ void load_q(bf16x8 (&qf)[4], const bf16_t* qrow, int hh) {
#pragma unroll
    for (int s = 0; s < 4; ++s) qf[s] = *(const bf16x8*)(qrow + 16 * s + 8 * hh);
}

__device__ __forceinline__ void attn_a_unit(int unit, const bf16_t* qk, const bf16_t* vT, const float* sink, bf16_t* ao, int lane) {
    const int r = lane & 31, hh = lane >> 5;
    const int qt = unit & 255, h = (unit >> 8) % 12, b = unit / (256 * 12), kvh = h / 3;
    const int q0 = 32 * qt, qrow = b * SEQ + q0 + r;
    bf16x8 qf[4]; load_q(qf, qk + (size_t)qrow * NAB + h * 64, hh);
    AttnSt st; attn_init(st, sink[h] * LOG2E, 1.f);
    const int tlo = qt - 4 < 0 ? 0 : qt - 4, thi = qt + 4 > 255 ? 255 : qt + 4;
    for (int t = tlo; t <= thi; ++t) {
        const int k0 = 32 * t;
        f32x16 bias;
#pragma unroll
        for (int i = 0; i < 16; ++i) { const int dk = (k0 + crow(i, hh)) - (q0 + r); bias[i] = (dk <= 128 && dk >= -128) ? 0.f : NEGINF; }
        attn_tile(st, qf, qk + (size_t)(b * SEQ + k0 + r) * NAB + 768 + kvh * 64, vT + (size_t)(kvh * 64 + r) * T + b * SEQ + k0, hh, bias);
    }
    attn_store(st, ao + (size_t)qrow * D + h * 64, hh);
}
__device__ __forceinline__ void attn_b_unit(int unit, const bf16_t* qk, const bf16_t* vT, bf16_t* obp, float* lse, int lane) {
    const int r = lane & 31, hh = lane >> 5;
    const int gi = unit >> 11, idx = unit & 2047, dsh = 2 * gi, d = 1 << dsh, ntile = 256 >> dsh, sub = SEQ >> dsh;
    const int ut = idx % ntile, rr = (idx / ntile) % d, sl = (idx >> 8) & 3, b = idx >> 10, hb = gi * 4 + sl;
    const int u0 = 32 * ut, qrow = b * SEQ + (u0 + r) * d + rr;
    bf16x8 qf[4]; load_q(qf, qk + (size_t)qrow * NAB + 1280 + hb * 64, hh);
    AttnSt st; attn_init(st, -1e30f, 0.f);
    const int tlo = ut - 2 < 0 ? 0 : ut - 2, thi = ut + 2 > ntile - 1 ? ntile - 1 : ut + 2;
    for (int t = tlo; t <= thi; ++t) {
        const int k0 = 32 * t;
        f32x16 bias;
#pragma unroll
        for (int i = 0; i < 16; ++i) { const int dk = (k0 + crow(i, hh)) - (u0 + r); bias[i] = (dk <= 64 && dk >= -64) ? 0.f : NEGINF; }
        attn_tile(st, qf, qk + (size_t)(b * SEQ + (k0 + r) * d + rr) * NAB + 2048 + hb * 64, vT + (size_t)(256 + hb * 64 + r) * T + b * SEQ + rr * sub + k0, hh, bias);
    }
    attn_store(st, obp + ((size_t)gi * T + qrow) * 256 + sl * 64, hh);
    if (hh == 0) lse[((size_t)gi * T + qrow) * 4 + sl] = st.m + __builtin_amdgcn_logf(st.l);
}
__device__ __forceinline__ void attn_c_unit(int unit, const bf16_t* qk, const bf16_t* vT, const float* rpb, bf16_t* ao, LAS float* rp, int lane) {
    const int r = lane & 31, hh = lane >> 5;
    const int hf = unit & 1, gi = (unit >> 1) & 127, h = (unit >> 8) & 15, b = unit >> 12;
    for (int x = lane; x < 465; x += 64) rp[x] = rpb[h * 465 + x] * LOG2E;
    asm volatile("s_waitcnt lgkmcnt(0)" ::: "memory");
    const int j = 32 * hf + r, qrow = b * SEQ + gi * 64 + j;
    int rs = gi - 4; rs = rs < 0 ? 0 : (rs > 120 ? 120 : rs);
    int cs = j - 8; cs = cs < 0 ? 0 : (cs > 48 ? 48 : cs);
    bf16x8 qf[4]; load_q(qf, qk + (size_t)qrow * NC + h * 64, hh);
    AttnSt st; attn_init(st, -1e30f, 0.f);
    for (int t = 0; t < 16; ++t) {
        const int a = t >> 1, kc0 = 32 * (t & 1), k0 = b * SEQ + (rs + a) * 64 + kc0;
        const int rbase = (rs + a - gi + 7) * 31 + 15 - j;
        f32x16 bias;
#pragma unroll
        for (int i = 0; i < 16; ++i) { const int c = kc0 + crow(i, hh); const bool ok = (c >= cs) && (c < cs + 16); bias[i] = ok ? rp[ok ? rbase + c : 0] : NEGINF; }
        attn_tile(st, qf, qk + (size_t)(k0 + r) * NC + 1024 + h * 64, vT + (size_t)(h * 64 + r) * T + k0, hh, bias);
    }
    attn_store(st, ao + (size_t)qrow * D + h * 64, hh);
}

__device__ __forceinline__ int dest_row(int mode, int n) {
    if (mode == 1) return 8 * (n >> 2) + (n & 3);
    if (mode == 2) return 8 * (n >> 2) + 4 + (n & 3);
    if (mode == 3) {
        if (n < 1024 || (n >= 1280 && n < 2816)) { const int d = n & 63, base = n - d, nn = d >> 5, dd = d & 31; return base + 32 * (dd >> 4) + 8 * ((dd & 15) >> 2) + 4 * nn + (dd & 3); }
        return n;
    }
    return n;
}
__device__ __forceinline__ void tr_item(const float* W, int K, int N, const float* gain, bf16_t* WT, int mode, LAS float* scr, int item, int lane) {
    const int nblk = N / 32, kb = item / nblk, nb = item % nblk, k0 = 64 * kb, n0 = 32 * nb;
#pragma unroll 8
    for (int i = 0; i < 32; ++i) { const int kk = 2 * i + (lane >> 5); scr[kk * 33 + (lane & 31)] = W[(size_t)(k0 + kk) * N + n0 + (lane & 31)]; }
    asm volatile("s_waitcnt lgkmcnt(0)" ::: "memory");
    const int c = lane & 7;
    f32x4 g0 = {1.f, 1.f, 1.f, 1.f}, g1 = g0;
    if (gain) { g0 = *(const f32x4*)(gain + k0 + 8 * c); g1 = *(const f32x4*)(gain + k0 + 8 * c + 4); }
#pragma unroll
    for (int jj = 0; jj < 4; ++jj) {
        const int n = (lane >> 3) + 8 * jj; const LAS float* s = scr + (8 * c) * 33 + n;
        u32x4 o; o.x = pk2(s[0 * 33] * g0[0], s[1 * 33] * g0[1]); o.y = pk2(s[2 * 33] * g0[2], s[3 * 33] * g0[3]);
        o.z = pk2(s[4 * 33] * g1[0], s[5 * 33] * g1[1]); o.w = pk2(s[6 * 33] * g1[2], s[7 * 33] * g1[3]);
        *(u32x4*)(WT + (size_t)dest_row(mode, n0 + n) * K + k0 + 8 * c) = o;
    }
    asm volatile("s_waitcnt lgkmcnt(0)" ::: "memory");
}

__device__ __forceinline__ int lane_id_opaque() { int l; asm volatile("v_mbcnt_lo_u32_b32 %0, -1, 0\n\tv_mbcnt_hi_u32_b32 %0, -1, %0" : "=&v"(l)); return l; }
struct Args {
    const float* in[21]; float* out; unsigned char* ws; int ph_lo, ph_hi;
};

__global__ void __launch_bounds__(NWAVES * 64, 2) mk_fwd(Args args) {
    extern __shared__ __attribute__((aligned(16))) unsigned char lds_raw[];
    LAS unsigned char* lds = (LAS unsigned char*)lds_raw;
    cg::grid_group grid = cg::this_grid();
    const int wave = __builtin_amdgcn_readfirstlane((int)threadIdx.x >> 6);
    const int G = gridDim.x, gw = blockIdx.x * NWAVES + wave, NGW = G * NWAVES, NGT = G * NWAVES * 64;
    unsigned char* ws = args.ws;
    const float* x = args.in[0]; const float* p_in = args.in[1];
    const float* norm_ffn1 = args.in[2]; const float* f1g = args.in[3]; const float* f1u = args.in[4]; const float* f1d = args.in[5];
    const float* norm_mix = args.in[6]; const float* w_in_ab = args.in[7]; const float* sink_a = args.in[8]; const float* w_out_ab = args.in[9];
    const float* w_in_c = args.in[10]; const float* rpb_c = args.in[11]; const float* w_out_c = args.in[12];
    const float* norm_ffn2 = args.in[13]; const float* f2g = args.in[14]; const float* f2u = args.in[15]; const float* f2d = args.in[16];
    const float* norm_ple = args.in[17]; const float* w_pg = args.in[18]; const float* w_pp = args.in[19]; const float* norm_final = args.in[20];
    float* h = args.out;
    float* ssq = (float*)(ws + WS_SSQ); float* ctab = (float*)(ws + WS_COS); float* stab = (float*)(ws + WS_SIN); float* lse = (float*)(ws + WS_LSE);
    bf16_t* Wb = (bf16_t*)(ws + WS_W); bf16_t* hb = (bf16_t*)(ws + WS_HB); bf16_t* act = (bf16_t*)(ws + WS_ACT); bf16_t* qk = act;
    bf16_t* vT = (bf16_t*)(ws + WS_VT); bf16_t* hb_alt = vT; bf16_t* ao = (bf16_t*)(ws + WS_AO); bf16_t* ppb = ao; bf16_t* obp = (bf16_t*)(ws + WS_OBP); bf16_t* pb = (bf16_t*)(ws + WS_PB);
    const int lo = args.ph_lo, hi = args.ph_hi;
    int pc = 0;
#define PHASE_BEGIN if (pc >= lo && pc < hi) { const int lane = lane_id_opaque(); const int tid = wave * 64 + lane; const int gtid = blockIdx.x * (NWAVES * 64) + tid; (void)gtid;
#define PHASE_END   if (pc + 1 < hi) grid.sync(); } ++pc;

    PHASE_BEGIN
    {
        LAS float* scr = (LAS float*)(lds + wave * 16384);
        constexpr int I_GU = 16 * 88, I_DN = 44 * 32, I_IN = 16 * 112, I_INC = 16 * 96, I_SQ = 16 * 32, I_PP = 4 * 32;
        constexpr int L_ITEMS = 6 * I_GU   + I_IN + 2 * I_SQ + I_PP;
        static_assert(I_GU == I_DN, "items");
        for (int it = gw; it < DEPTH * L_ITEMS; it += NGW) {
            const int li = it / L_ITEMS; int r = it % L_ITEMS; const int j = li >> 1;
            bf16_t* Wl = Wb + (size_t)li * LAYER_W;
            const size_t fo = (size_t)li * D * FF;
            if (r < I_GU) { tr_item(f1g + fo, D, FF, norm_ffn1 + li * D, Wl + O_GU1, 1, scr, r, lane); continue; } r -= I_GU;
            if (r < I_GU) { tr_item(f1u + fo, D, FF, norm_ffn1 + li * D, Wl + O_GU1, 2, scr, r, lane); continue; } r -= I_GU;
            if (r < I_DN) { tr_item(f1d + fo, FF, D, nullptr, Wl + O_D1, 0, scr, r, lane); continue; } r -= I_DN;
            if (r < I_GU) { tr_item(f2g + fo, D, FF, norm_ffn2 + li * D, Wl + O_GU2, 1, scr, r, lane); continue; } r -= I_GU;
            if (r < I_GU) { tr_item(f2u + fo, D, FF, norm_ffn2 + li * D, Wl + O_GU2, 2, scr, r, lane); continue; } r -= I_GU;
            if (r < I_DN) { tr_item(f2d + fo, FF, D, nullptr, Wl + O_D2, 0, scr, r, lane); continue; } r -= I_DN;
            if (r < I_IN) {
                if ((li & 1) == 0) tr_item(w_in_ab + (size_t)j * D * NAB, D, NAB, norm_mix + li * D, Wl + O_IN, 3, scr, r, lane);
                else if (r < I_INC) tr_item(w_in_c + (size_t)j * D * NC, D, NC, norm_mix + li * D, Wl + O_IN, 0, scr, r, lane);
                continue; } r -= I_IN;
            if (r < I_SQ) { tr_item(((li & 1) == 0 ? w_out_ab : w_out_c) + (size_t)j * D * D, D, D, nullptr, Wl + O_OUT, 0, scr, r, lane); continue; } r -= I_SQ;
            if (r < I_SQ) { tr_item(w_pg + (size_t)li * D * D, D, D, norm_ple + li * D, Wl + O_PG, 0, scr, r, lane); continue; } r -= I_SQ;
            tr_item(w_pp + (size_t)li * PLE * D, PLE, D, nullptr, Wl + O_PP, 0, scr, r, lane);
        }
        for (int m = gw; m < T; m += NGW) {
            const f32x4* xr = (const f32x4*)(x + (size_t)m * D) + lane; f32x4* hr = (f32x4*)(h + (size_t)m * D) + lane; u32x2* br = (u32x2*)(hb + (size_t)m * D) + lane;
            float s = 0.f;
#pragma unroll
            for (int q = 0; q < 4; ++q) { const f32x4 v = xr[64 * q]; hr[64 * q] = v; u32x2 w; w.x = pk2(v[0], v[1]); w.y = pk2(v[2], v[3]); br[64 * q] = w; s += (v[0] * v[0] + v[1] * v[1]) + (v[2] * v[2] + v[3] * v[3]); }
            s = wave_sum(s);
            if (lane == 0) ssq[m] = s;
        }
        for (int i = gtid; i < 16 * T; i += NGT) ssq[T + i] = 0.f;
        for (int i = gtid; i < DEPTH * T * PLE / 8; i += NGT) {
            const f32x4 a = ((const f32x4*)p_in)[2 * i], c = ((const f32x4*)p_in)[2 * i + 1];
            u32x4 w; w.x = pk2(a[0], a[1]); w.y = pk2(a[2], a[3]); w.z = pk2(c[0], c[1]); w.w = pk2(c[2], c[3]);
            ((u32x4*)pb)[i] = w;
        }
        for (int i = gtid; i < SEQ * 32; i += NGT) {
            const int pos = i >> 5, dd = i & 31;
            const float inv = exp2f(-(float)dd * (13.287712379549449f / 32.f));
            const float ang = (float)pos * inv;
            double rev = (double)ang * 0.15915494309189535; rev -= __builtin_rint(rev);
            const float rv = (float)rev;
            ctab[i] = __builtin_amdgcn_cosf(rv); stab[i] = __builtin_amdgcn_sinf(rv);
        }
    }
    PHASE_END

#pragma unroll 1
    for (int li = 0; li < DEPTH; ++li) {
        const bf16_t* Wl = Wb + (size_t)li * LAYER_W;
        const int j = li >> 1;
        float* sq = ssq + (size_t)(4 * li) * T;
        PHASE_BEGIN
        { pg8::Gemm g{li == 0 ? hb : hb_alt, Wl + O_GU1, T, NGU, D}; pg8::StaticOrder S; S.init(T, NGU, G, (int)blockIdx.x);
          EpiGateUp E{act, sq};
          pg8::gemm_phase<EpiGateUp, pg8::StaticOrder, true, true>(lds, g, S, E, tid); }
        PHASE_END
        PHASE_BEGIN
        { pg8::Gemm g{act, Wl + O_D1, T, D, FF}; pg8::StaticOrder S; S.init(T, D, G, (int)blockIdx.x);
          EpiRes<0> E{h, hb, sq + T, nullptr, nullptr, 0.5f};
          pg8::gemm_phase<EpiRes<0>, pg8::StaticOrder, false, true>(lds, g, S, E, tid); }
        PHASE_END
        if ((li & 1) == 0) {
            PHASE_BEGIN
            { pg8::Gemm g{hb, Wl + O_IN, T, NAB, D}; pg8::StaticOrder S; S.init(T, NAB, G, (int)blockIdx.x);
              EpiQKV<1> E{qk, vT, sq + T, ctab, stab};
              pg8::gemm_phase<EpiQKV<1>, pg8::StaticOrder, true, true>(lds, g, S, E, tid); }
            PHASE_END
            PHASE_BEGIN
            for (int unit = gw; unit < 12288; unit += NGW) {
                if (unit < 6144) attn_a_unit(unit, qk, vT, sink_a + j * 12, ao, lane);
                else attn_b_unit(unit - 6144, qk, vT, obp, lse, lane);
            }
            PHASE_END
            PHASE_BEGIN
            for (int i = gtid; i < T * 32; i += NGT) {
                const int row = i >> 5, c8 = (i & 31) * 8, sl = c8 >> 6;
                const float l0 = lse[(size_t)row * 4 + sl], l1 = lse[((size_t)T + row) * 4 + sl], l2 = lse[((size_t)2 * T + row) * 4 + sl];
                const float mx = fmaxf(l0, fmaxf(l1, l2));
                float w0 = fexp2(l0 - mx), w1 = fexp2(l1 - mx), w2 = fexp2(l2 - mx);
                const float inv = 1.f / (w0 + w1 + w2); w0 *= inv; w1 *= inv; w2 *= inv;
                const u32x4 a = *(const u32x4*)(obp + (size_t)row * 256 + c8), bq = *(const u32x4*)(obp + ((size_t)T + row) * 256 + c8), c = *(const u32x4*)(obp + ((size_t)2 * T + row) * 256 + c8);
                u32x4 o;
                o.x = pk2(w0 * bflo(a.x) + w1 * bflo(bq.x) + w2 * bflo(c.x), w0 * bfhi(a.x) + w1 * bfhi(bq.x) + w2 * bfhi(c.x));
                o.y = pk2(w0 * bflo(a.y) + w1 * bflo(bq.y) + w2 * bflo(c.y), w0 * bfhi(a.y) + w1 * bfhi(bq.y) + w2 * bfhi(c.y));
                o.z = pk2(w0 * bflo(a.z) + w1 * bflo(bq.z) + w2 * bflo(c.z), w0 * bfhi(a.z) + w1 * bfhi(bq.z) + w2 * bfhi(c.z));
                o.w = pk2(w0 * bflo(a.w) + w1 * bflo(bq.w) + w2 * bflo(c.w), w0 * bfhi(a.w) + w1 * bfhi(bq.w) + w2 * bfhi(c.w));
                *(u32x4*)(ao + (size_t)row * D + 768 + c8) = o;
            }
            PHASE_END
        } else {
            PHASE_BEGIN
            { pg8::Gemm g{hb, Wl + O_IN, T, NC, D}; pg8::StaticOrder S; S.init(T, NC, G, (int)blockIdx.x);
              EpiQKV<0> E{qk, vT, sq + T, ctab, stab};
              pg8::gemm_phase<EpiQKV<0>, pg8::StaticOrder, true, true>(lds, g, S, E, tid); }
            PHASE_END
            PHASE_BEGIN
            { LAS float* rp = (LAS float*)(lds + wave * 2048);
              for (int unit = gw; unit < 8192; unit += NGW) attn_c_unit(unit, qk, vT, rpb_c + (size_t)j * 16 * 465, ao, rp, lane); }
            PHASE_END
        }
        PHASE_BEGIN
        { pg8::Gemm g{ao, Wl + O_OUT, T, D, D}; pg8::StaticOrder S; S.init(T, D, G, (int)blockIdx.x);
          EpiRes<0> E{h, hb, sq + 2 * T, nullptr, nullptr, 1.0f};
          pg8::gemm_phase<EpiRes<0>, pg8::StaticOrder, false, true>(lds, g, S, E, tid); }
        PHASE_END
        PHASE_BEGIN
        { pg8::Gemm g{hb, Wl + O_GU2, T, NGU, D}; pg8::StaticOrder S; S.init(T, NGU, G, (int)blockIdx.x);
          EpiGateUp E{act, sq + 2 * T};
          pg8::gemm_phase<EpiGateUp, pg8::StaticOrder, true, true>(lds, g, S, E, tid); }
        { pg8::Gemm g{pb + (size_t)li * T * PLE, Wl + O_PP, T, D, PLE}; pg8::StaticOrder S; S.init(T, D, G, (int)blockIdx.x);
          EpiPlain E{ppb};
          pg8::gemm_phase<EpiPlain, pg8::StaticOrder, false, true>(lds, g, S, E, tid); }
        PHASE_END
        PHASE_BEGIN
        { pg8::Gemm g{act, Wl + O_D2, T, D, FF}; pg8::StaticOrder S; S.init(T, D, G, (int)blockIdx.x);
          EpiRes<0> E{h, hb, sq + 3 * T, nullptr, nullptr, 0.5f};
          pg8::gemm_phase<EpiRes<0>, pg8::StaticOrder, false, true>(lds, g, S, E, tid); }
        PHASE_END
        PHASE_BEGIN
        { pg8::Gemm g{hb, Wl + O_PG, T, D, D}; pg8::StaticOrder S; S.init(T, D, G, (int)blockIdx.x);
          EpiRes<1> E{h, hb_alt, sq + 4 * T, sq + 3 * T, ppb, 1.0f};
          pg8::gemm_phase<EpiRes<1>, pg8::StaticOrder, false, true>(lds, g, S, E, tid); }
        PHASE_END
    }
    PHASE_BEGIN
    {
        const float* sq = ssq + (size_t)16 * T;
        for (int i = gtid; i < T * D / 4; i += NGT) {
            const int row = i >> 8, c4 = (i & 255) * 4;
            const float r = __builtin_amdgcn_rsqf(sq[row] * (1.f / 1024.f) + EPS);
            f32x4 v = ((const f32x4*)h)[i]; const f32x4 gg = *(const f32x4*)(norm_final + c4);
            v = v * r * gg; ((f32x4*)h)[i] = v;
        }
    }
    PHASE_END
#undef PHASE_BEGIN
#undef PHASE_END
}

constexpr int N_PHASES = 1 + 9 + 8 + 9 + 8 + 1;

extern "C" void kernel_launch(void* const* d_in, const int* in_sizes, int n_in, void* d_out, int out_size, void* d_ws, size_t ws_size, hipStream_t stream) {
    static int grid = 0;
    if (grid == 0) {
        if (n_in != 21 || out_size != T * D || ws_size < WS_END) { fprintf(stderr, "kernel_launch: unexpected shapes (n_in %d out %d ws %zu)\n", n_in, out_size, ws_size); grid = -1; return; }
        int dev = 0, cus = 0, per_cu = 0;
        hipGetDevice(&dev); hipDeviceGetAttribute(&cus, hipDeviceAttributeMultiprocessorCount, dev);
        hipFuncSetAttribute((const void*)mk_fwd, hipFuncAttributeMaxDynamicSharedMemorySize, LDS_BYTES);
        hipOccupancyMaxActiveBlocksPerMultiprocessor(&per_cu, (const void*)mk_fwd, NWAVES * 64, LDS_BYTES);
        if (per_cu < 1) { fprintf(stderr, "kernel_launch: occupancy query says %d blocks per CU\n", per_cu); per_cu = 1; }
        (void)hipGetLastError();
        grid = cus * per_cu;
    }
    if (grid < 0) return;
    Args a{};
    for (int i = 0; i < 21; ++i) a.in[i] = (const float*)d_in[i];
    a.out = (float*)d_out; a.ws = (unsigned char*)d_ws;
#if MK_COOP
    a.ph_lo = 0; a.ph_hi = N_PHASES;
    void* kargs[] = {&a};
    hipError_t e = hipLaunchCooperativeKernel((const void*)mk_fwd, dim3(grid), dim3(NWAVES * 64), kargs, LDS_BYTES, stream);
    if (e != hipSuccess) fprintf(stderr, "cooperative launch failed: %s (grid %d)\n", hipGetErrorString(e), grid);
#else
    for (int p = 0; p < N_PHASES; ++p) {
        a.ph_lo = p; a.ph_hi = p + 1;
        hipLaunchKernelGGL(mk_fwd, dim3(grid), dim3(NWAVES * 64), LDS_BYTES, stream, a);
    }
#endif
}
```

```cpp
#include <hip/hip_runtime.h>
#include <hip/hip_cooperative_groups.h>
#include <cstdio>
#include <cstdint>
namespace cg = cooperative_groups;
namespace pg8 {
#define PG8_LAS __attribute__((address_space(3)))
typedef unsigned short bf16_t;
typedef short bf16x8 __attribute__((ext_vector_type(8)));
typedef float f32x4 __attribute__((ext_vector_type(4)));
typedef unsigned u32x4 __attribute__((ext_vector_type(4)));
constexpr int BM = 256, BK = 64, HALF = 128, HTB = HALF * BK * 2  , STAGE_BYTES = 8 * HTB, NXCD = 8, WGM = 8;

__host__ __device__ __forceinline__ int lds_byte(int r, int c) { const int st = (r >> 4) * 2 + (c >> 5), rr = r & 15, cc = c & 31, ob = rr * 64 + cc * 2; return st * 1024 + (ob ^ (((ob >> 9) & 1) << 5)); }
__host__ __device__ __forceinline__ void stage_rc(int b, int& R, int& C) { const int st = b / 1024, sb = b % 1024, swz = sb ^ (((sb >> 9) & 1) << 5); R = (st >> 1) * 16 + swz / 64; C = (st & 1) * 32 + (swz % 64) / 2; }
__host__ __device__ __forceinline__ int perm32(int rho) { const int n = rho >> 4, i = rho & 15; return 8 * (i >> 2) + 4 * n + (i & 3); }

struct Unit { int pm, pn; };
struct Gemm { const bf16_t* A; const bf16_t* Bt; int M, N, K; };

struct StaticOrder {
    int nM, nN, nwg, G, c;
    __host__ __device__ void init(int M, int N, int G_, int c_) { nM = M / BM; nN = N / BM; nwg = nM * nN; G = G_; c = c_; }
    __host__ __device__ bool next(int i, Unit& u) const {
        const long L = (long)i * G + c; if (L >= nwg) return false;
        int wgid = (int)L; { const int q = nwg / NXCD, r = nwg % NXCD, xcd = wgid % NXCD, off = wgid / NXCD; wgid = (xcd < r ? xcd * (q + 1) : r * (q + 1) + (xcd - r) * q) + off; }
        const int nig = WGM * nN, gid = wgid / nig, fm = gid * WGM, gsz = (nM - fm) < WGM ? (nM - fm) : WGM;
        u.pm = fm + ((wgid % nig) % gsz); u.pn = (wgid % nig) / gsz; return true;
    }
    __device__ __forceinline__ void a_ready(const Unit&) const {}
    __device__ __forceinline__ void done(const Unit&) const {}
};


template <class Epi, class Sched, bool ALIGN_EPI = false, bool SP2 = false>
__device__ __forceinline__ void gemm_phase(PG8_LAS unsigned char* lds, const Gemm g, const Sched& S, const Epi& E, int tid_in) {
    int tid_o = tid_in; asm volatile("" : "+v"(tid_o));
    const int tid = tid_o, wid = __builtin_amdgcn_readfirstlane(tid >> 6), lane = tid & 63, wr = wid >> 2, wc = wid & 3, fr = lane & 15, fq = lane >> 4;
    const int K = g.K, nt = K / BK;
    unsigned voffA[2], voffB[2];
#pragma unroll
    for (int i = 0; i < 2; ++i) { int R, C; stage_rc(tid * 16 + i * 8192, R, C); const int Rb = Epi::PERM ? ((R & ~31) + perm32(R & 31)) : R;
        voffA[i] = (unsigned)(R * K + C) * 2u; voffB[i] = (unsigned)(Rb * K + C) * 2u; }
    const size_t kstep = (size_t)(BK * 2);
    const size_t hstep = (size_t)HALF * K * 2;
    const size_t tstep = 2 * hstep;
    const unsigned ldsw = (unsigned)wid * 1024u;
    const int aoff = lds_byte(wr * 64 + fr, fq * 8), boff = lds_byte(wc * 32 + fr, fq * 8);
#define PG8_SA(b, h) (((b) * 2 + (h)) * HTB)
#define PG8_SB(b, h) ((4 + (b) * 2 + (h)) * HTB)
#define PG8_STAGE(bufoff, gbase, voff) do { _Pragma("unroll") for (int _i = 0; _i < 2; ++_i) \
        __builtin_amdgcn_global_load_lds((const unsigned*)((const char*)(gbase) + (voff)[_i]), (PG8_LAS unsigned*)(lds + (bufoff) + ldsw + _i * 8192), 16, 0, 0); } while (0)
#define PG8_LDA(dst, b, h) do { _Pragma("unroll") for (int m = 0; m < 4; ++m) _Pragma("unroll") for (int k = 0; k < 2; ++k) dst[m][k] = *(const PG8_LAS bf16x8*)(lds + PG8_SA(b, h) + aoff + m * 2048 + k * 1024); } while (0)
#define PG8_LDB(dst, b, h) do { _Pragma("unroll") for (int n = 0; n < 2; ++n) _Pragma("unroll") for (int k = 0; k < 2; ++k) dst[n][k] = *(const PG8_LAS bf16x8*)(lds + PG8_SB(b, h) + boff + n * 2048 + k * 1024); } while (0)
#define PG8_MMA(ai, bj, At, Bt) do { __builtin_amdgcn_s_setprio(1); _Pragma("unroll") for (int m = 0; m < 4; ++m) _Pragma("unroll") for (int n = 0; n < 2; ++n) _Pragma("unroll") for (int k = 0; k < 2; ++k) \
        acc[ai][bj][m][n] = __builtin_amdgcn_mfma_f32_16x16x32_bf16(Bt[n][k], At[m][k], acc[ai][bj][m][n], 0, 0, 0); __builtin_amdgcn_s_setprio(0); } while (0)
#define PG8_WAIT_V(n) asm volatile("s_waitcnt vmcnt(" #n ")" ::: "memory")
#define PG8_WAIT_L(n) asm volatile("s_waitcnt lgkmcnt(" #n ")" ::: "memory")
#define PG8_BAR __builtin_amdgcn_s_barrier()
#define PG8_SCHED __builtin_amdgcn_sched_barrier(0)
    Unit cur, nxt; int ui = 0;
    if (!S.next(0, cur)) return;
    f32x4 acc[2][2][4][2];
#pragma unroll
    for (int a = 0; a < 2; ++a)
#pragma unroll
        for (int b = 0; b < 2; ++b)
#pragma unroll
            for (int m = 0; m < 4; ++m)
#pragma unroll
                for (int n = 0; n < 2; ++n) acc[a][b][m][n] = (f32x4){0.f, 0.f, 0.f, 0.f};
    bf16x8 At[4][2], B0[2][2], B1[2][2];
    const char* cA = (const char*)g.A + (size_t)cur.pm * tstep; const char* cB = (const char*)g.Bt + (size_t)cur.pn * tstep;
    S.a_ready(cur);
    if constexpr (SP2) {
        PG8_STAGE(PG8_SB(0, 0), cB, voffB); PG8_STAGE(PG8_SB(0, 1), cB + hstep, voffB); PG8_STAGE(PG8_SA(0, 0), cA, voffA); PG8_STAGE(PG8_SA(0, 1), cA + hstep, voffA);
        if (wr == 1) PG8_BAR;
        PG8_WAIT_V(2); PG8_BAR;
        PG8_STAGE(PG8_SB(1, 0), cB + kstep, voffB); PG8_STAGE(PG8_SA(1, 0), cA + kstep, voffA); PG8_STAGE(PG8_SB(1, 1), cB + hstep + kstep, voffB);
        PG8_WAIT_V(6); PG8_BAR;
    } else {
        PG8_STAGE(PG8_SB(0, 0), cB, voffB); PG8_STAGE(PG8_SA(0, 0), cA, voffA); PG8_STAGE(PG8_SB(0, 1), cB + hstep, voffB); PG8_STAGE(PG8_SA(0, 1), cA + hstep, voffA);
        if (wr == 1) PG8_BAR;
        PG8_WAIT_V(4); PG8_BAR;
        PG8_STAGE(PG8_SB(1, 0), cB + kstep, voffB); PG8_STAGE(PG8_SA(1, 0), cA + kstep, voffA); PG8_STAGE(PG8_SB(1, 1), cB + hstep + kstep, voffB);
        PG8_WAIT_V(6); PG8_BAR;
    }
    for (;;) {
        const bool has_next = S.next(ui + 1, nxt);
        const char* nA = has_next ? (const char*)g.A + (size_t)nxt.pm * tstep : cA; const char* nB = has_next ? (const char*)g.Bt + (size_t)nxt.pn * tstep : cB;
        for (int t = 0; t < nt; t += 2) {
            const bool last = (t == nt - 2);
            const char* a1 = cA + (size_t)(t + 1) * kstep;
            const char* a2 = last ? nA : cA + (size_t)(t + 2) * kstep; const char* b2 = last ? nB : cB + (size_t)(t + 2) * kstep;
            const char* a3 = a2 + kstep; const char* b3 = b2 + kstep;
            if (last && has_next) S.a_ready(nxt);
            if constexpr (SP2) {
            PG8_LDB(B0, 0, 0); PG8_LDB(B1, 0, 1); PG8_SCHED; PG8_LDA(At, 0, 0); PG8_STAGE(PG8_SA(1, 1), a1 + hstep, voffA);
            PG8_WAIT_V(8); PG8_WAIT_L(0); PG8_BAR; PG8_MMA(0, 0, At, B0); PG8_MMA(0, 1, At, B1); PG8_BAR; PG8_SCHED;
            PG8_LDA(At, 0, 1); PG8_STAGE(PG8_SB(0, 0), b2, voffB); PG8_STAGE(PG8_SB(0, 1), b2 + hstep, voffB); PG8_STAGE(PG8_SA(0, 0), a2, voffA);
            PG8_WAIT_V(8); PG8_WAIT_L(0); PG8_BAR; PG8_MMA(1, 0, At, B0); PG8_MMA(1, 1, At, B1); PG8_BAR; PG8_SCHED;
            PG8_LDB(B0, 1, 0); PG8_LDB(B1, 1, 1); PG8_SCHED; PG8_LDA(At, 1, 0); PG8_STAGE(PG8_SA(0, 1), a2 + hstep, voffA);
            PG8_WAIT_V(8); PG8_WAIT_L(0); PG8_BAR; PG8_MMA(0, 0, At, B0); PG8_MMA(0, 1, At, B1); PG8_BAR; PG8_SCHED;
            PG8_LDA(At, 1, 1); PG8_STAGE(PG8_SB(1, 0), b3, voffB); PG8_STAGE(PG8_SB(1, 1), b3 + hstep, voffB); PG8_STAGE(PG8_SA(1, 0), a3, voffA);
            PG8_WAIT_V(8); PG8_WAIT_L(0); PG8_BAR; PG8_MMA(1, 0, At, B0); PG8_MMA(1, 1, At, B1); PG8_BAR; PG8_SCHED;
            } else {
            PG8_LDB(B0, 0, 0); PG8_SCHED; PG8_LDA(At, 0, 0); PG8_STAGE(PG8_SA(1, 1), a1 + hstep, voffA);
            PG8_WAIT_L(8); PG8_BAR; PG8_WAIT_L(0); PG8_MMA(0, 0, At, B0); PG8_BAR; PG8_SCHED;
            PG8_LDB(B1, 0, 1); PG8_STAGE(PG8_SB(0, 0), b2, voffB);
            PG8_BAR; PG8_WAIT_L(0); PG8_MMA(0, 1, At, B1); PG8_BAR;
            PG8_LDA(At, 0, 1); PG8_STAGE(PG8_SA(0, 0), a2, voffA);
            PG8_BAR; PG8_WAIT_L(0); PG8_MMA(1, 0, At, B0); PG8_BAR; PG8_SCHED;
            PG8_STAGE(PG8_SB(0, 1), b2 + hstep, voffB);
            PG8_WAIT_V(6); PG8_BAR; PG8_MMA(1, 1, At, B1); PG8_BAR;
            PG8_LDB(B0, 1, 0); PG8_SCHED; PG8_LDA(At, 1, 0); PG8_STAGE(PG8_SA(0, 1), a2 + hstep, voffA);
            PG8_WAIT_L(8); PG8_BAR; PG8_WAIT_L(0); PG8_MMA(0, 0, At, B0); PG8_BAR; PG8_SCHED;
            PG8_LDB(B1, 1, 1); PG8_STAGE(PG8_SB(1, 0), b3, voffB);
            PG8_BAR; PG8_WAIT_L(0); PG8_MMA(0, 1, At, B1); PG8_BAR;
            PG8_LDA(At, 1, 1); PG8_STAGE(PG8_SA(1, 0), a3, voffA);
            PG8_BAR; PG8_WAIT_L(0); PG8_MMA(1, 0, At, B0); PG8_BAR; PG8_SCHED;
            PG8_STAGE(PG8_SB(1, 1), b3 + hstep, voffB);
            PG8_WAIT_V(6); PG8_BAR; PG8_MMA(1, 1, At, B1); PG8_BAR;
            }
        }
        if constexpr (ALIGN_EPI) { if (wr == 0) PG8_BAR; }
        if constexpr (!Epi::AFTER_DRAIN) { E(acc, cur, wr, wc, fr, fq); S.done(cur); }
        if (!has_next) break;
#pragma unroll
        for (int a = 0; a < 2; ++a)
#pragma unroll
            for (int b = 0; b < 2; ++b)
#pragma unroll
                for (int m = 0; m < 4; ++m)
#pragma unroll
                    for (int n = 0; n < 2; ++n) acc[a][b][m][n] = (f32x4){0.f, 0.f, 0.f, 0.f};
        cur = nxt; cA = nA; cB = nB; ++ui;
        if constexpr (ALIGN_EPI) { if (wr == 1) PG8_BAR; }
    }
    PG8_WAIT_V(0);
    if constexpr (!ALIGN_EPI) { if (wr == 0) PG8_BAR; }
    PG8_BAR;
    if constexpr (Epi::AFTER_DRAIN) { E.fused(acc, cur, wr, wc, fr, fq, lds, wid, lane); S.done(cur); }
#undef PG8_SA
#undef PG8_SB
#undef PG8_STAGE
#undef PG8_LDA
#undef PG8_LDB
#undef PG8_MMA
#undef PG8_WAIT_V
#undef PG8_WAIT_L
#undef PG8_BAR
#undef PG8_SCHED
}
}

#define LAS __attribute__((address_space(3)))
typedef unsigned short bf16_t;
typedef short bf16x8 __attribute__((ext_vector_type(8)));
typedef short s16x4 __attribute__((ext_vector_type(4)));
typedef float f32x4 __attribute__((ext_vector_type(4)));
typedef float f32x16 __attribute__((ext_vector_type(16)));
typedef unsigned u32x4 __attribute__((ext_vector_type(4)));
typedef unsigned u32x2 __attribute__((ext_vector_type(2)));

#ifndef MK_DBL
#define MK_DBL 0
#endif
#ifndef MK_BF16RES
#define MK_BF16RES 2
#endif
#ifndef MK_PF2
#define MK_PF2 1
#endif
#ifndef MK_LOCALBAR
#define MK_LOCALBAR 0
#endif
#ifndef MK_LATECONV
#define MK_LATECONV 0
#endif
#ifndef MK_NQ2
#define MK_NQ2 0
#endif
#ifndef MK_COOP
#define MK_COOP 1
#endif

constexpr int NWAVES = 8;
constexpr int T = 16384, SEQ = 8192, D = 1024, FF = 2816, NGU = 5632, NAB = 3584, NC = 3072, PLE = 256, DEPTH = 4;
constexpr int LDAB = NAB + 64, LDC = NC + 64;
__host__ __device__ constexpr size_t vt_off(int vhead, int tidx) { return ((size_t)vhead * (16384 / 64) + (size_t)(tidx >> 6)) * 4096 + (size_t)(tidx & 63); }
constexpr float EPS = 1e-6f;
constexpr float LOG2E = 1.4426950408889634f;
constexpr float SC2 = 0.125f * LOG2E;
constexpr float NEGINF = -__builtin_huge_valf();

constexpr size_t O_GU1 = 0, O_D1 = 5767168, O_GU2 = 8650752, O_D2 = 14417920, O_IN = 17301504, O_OUT = 20971520, O_PG = 22020096, O_PP = 23068672, LAYER_W = 23330816;
constexpr size_t MiB = 1u << 20;
constexpr size_t WS_SSQ = 1 * MiB, WS_COS = 3 * MiB, WS_SIN = 4 * MiB, WS_LSE = 5 * MiB, WS_W = 6 * MiB, WS_HB = 184 * MiB, WS_ACT = 216 * MiB,
                 WS_VT = 332 * MiB, WS_AO = 366 * MiB, WS_OBP = 398 * MiB, WS_PB = 422 * MiB, WS_SSQP = 454 * MiB, WS_HL8 = 458 * MiB, WS_END = 474 * MiB;
static_assert(WS_W + LAYER_W * 4 * 2 <= WS_HB && WS_ACT + (size_t)T * LDAB * 2 <= WS_VT && WS_VT + (size_t)1024 * T * 2 <= WS_AO, "ws map");
constexpr int RT_OFF = 131072 + 1024, LDS_BYTES = RT_OFF + 8192;

__device__ __forceinline__ unsigned f2bf(float f) { unsigned u = __builtin_bit_cast(unsigned, f); return (u + 0x7fffu + ((u >> 16) & 1u)) >> 16; }
__device__ __forceinline__ unsigned pk2(float lo, float hi) {
    typedef float f2_t __attribute__((ext_vector_type(2))); typedef __bf16 b2_t __attribute__((ext_vector_type(2)));
    f2_t v = {lo, hi}; b2_t b = __builtin_convertvector(v, b2_t); return __builtin_bit_cast(unsigned, b);
}
__device__ __forceinline__ float bflo(unsigned w) { return __builtin_bit_cast(float, w << 16); }
__device__ __forceinline__ float bfhi(unsigned w) { return __builtin_bit_cast(float, w & 0xffff0000u); }
__device__ __forceinline__ float wave_sum(float v) {
#pragma unroll
    for (int o = 1; o < 64; o <<= 1) v += __shfl_xor(v, o);
    return v;
}
__device__ __forceinline__ float fexp2(float x) { return __builtin_amdgcn_exp2f(x); }
__device__ __forceinline__ float frcp(float x) { return __builtin_amdgcn_rcpf(x); }
__device__ __forceinline__ float sigmoidf_(float x) { return frcp(1.f + fexp2(-x * LOG2E)); }

typedef unsigned long long u64;
constexpr float SSQ_FX = 16777216.f;
__device__ __forceinline__ float row_rstd(const u64* ssq, int row) { return __builtin_amdgcn_rsqf((float)ssq[row] * (1.f / (1024.f * SSQ_FX)) + EPS); }
__device__ __forceinline__ int lane_id_opaque() { int l; asm volatile("v_mbcnt_lo_u32_b32 %0, -1, 0\n\tv_mbcnt_hi_u32_b32 %0, -1, %0" : "=&v"(l)); return l; }
__device__ __forceinline__ float lo8_dec(float hi, int q) { const unsigned ex = __builtin_bit_cast(unsigned, hi) & 0x7f800000u; const float sc = ex >= (16u << 23) ? __builtin_bit_cast(float, ex - (15u << 23)) : 0.f; return hi + (float)q * sc; }
__device__ __forceinline__ unsigned lo8_enc(float h, float hi) {
    const unsigned ex = __builtin_bit_cast(unsigned, hi) & 0x7f800000u; const float isc = ex >= (16u << 23) ? __builtin_bit_cast(float, (269u << 23) - ex) : 0.f;
    int q = (int)__builtin_rintf((h - hi) * isc); q = q < -128 ? -128 : (q > 127 ? 127 : q); return (unsigned)q & 0xffu;
}
__device__ __forceinline__ int sb(unsigned w, int k) { return (int)(w << (24 - 8 * k)) >> 24; }
__host__ __device__ constexpr int lo8_pos(int c) { return (c & ~255) + ((c >> 5) & 3) * 64 + ((c >> 3) & 3) * 16 + ((c >> 7) & 1) * 8 + (c & 7); }
__device__ __forceinline__ void res_dec8(const u32x4 hi, const u32x2 lo, f32x4& h0, f32x4& h1) {
    h0[0] = lo8_dec(bflo(hi.x), sb(lo.x, 0)); h0[1] = lo8_dec(bfhi(hi.x), sb(lo.x, 1)); h0[2] = lo8_dec(bflo(hi.y), sb(lo.x, 2)); h0[3] = lo8_dec(bfhi(hi.y), sb(lo.x, 3));
    h1[0] = lo8_dec(bflo(hi.z), sb(lo.y, 0)); h1[1] = lo8_dec(bfhi(hi.z), sb(lo.y, 1)); h1[2] = lo8_dec(bflo(hi.w), sb(lo.y, 2)); h1[3] = lo8_dec(bfhi(hi.w), sb(lo.y, 3));
}
__device__ __forceinline__ void res_enc8(const f32x4 h0, const f32x4 h1, u32x4& hi, u32x2& lo) {
    hi.x = pk2(h0[0], h0[1]); hi.y = pk2(h0[2], h0[3]); hi.z = pk2(h1[0], h1[1]); hi.w = pk2(h1[2], h1[3]);
    lo.x = lo8_enc(h0[0], bflo(hi.x)) | (lo8_enc(h0[1], bfhi(hi.x)) << 8) | (lo8_enc(h0[2], bflo(hi.y)) << 16) | (lo8_enc(h0[3], bfhi(hi.y)) << 24);
    lo.y = lo8_enc(h1[0], bflo(hi.z)) | (lo8_enc(h1[1], bfhi(hi.z)) << 8) | (lo8_enc(h1[2], bflo(hi.w)) << 16) | (lo8_enc(h1[3], bfhi(hi.w)) << 24);
}
using pg8::Unit;

struct EpiGateUp {
    static constexpr bool PERM = true, AFTER_DRAIN = false;
    bf16_t* O; const u64* ssq; const LAS float* rt;
    __device__ __forceinline__ void operator()(const f32x4 (&acc)[2][2][4][2], const Unit& u, int wr, int wc, int fr_, int fq_) const {
        const int l_ = lane_id_opaque(), fr = l_ & 15, fq = l_ >> 4; (void)fr_; (void)fq_;
        const int row0 = u.pm * 256 + wr * 64 + fr;
        float rv[2][4];
        if (rt) {
#pragma unroll
            for (int ai = 0; ai < 2; ++ai)
#pragma unroll
                for (int m = 0; m < 4; ++m) rv[ai][m] = rt[(row0 + ai * 128 + m * 16) & 2047];
        } else {
#pragma unroll
            for (int ai = 0; ai < 2; ++ai)
#pragma unroll
                for (int m = 0; m < 4; ++m) rv[ai][m] = __builtin_amdgcn_rsqf((float)ssq[row0 + ai * 128 + m * 16] * (1.f / (1024.f * SSQ_FX)) + EPS);
        }
#pragma unroll
        for (int ai = 0; ai < 2; ++ai)
#pragma unroll
            for (int m = 0; m < 4; ++m) {
                __builtin_amdgcn_sched_barrier(0); const int row = row0 + ai * 128 + m * 16;
                const float r = rv[ai][m];
                u32x4 w;
#pragma unroll
                for (int n = 0; n < 2; ++n) {
                    const f32x4 ag = acc[ai][0][m][n], gu = ag * acc[ai][1][m][n];
                    const f32x4 ex = ag * (-r * LOG2E);
                    f32x4 den = {fexp2(ex[0]), fexp2(ex[1]), fexp2(ex[2]), fexp2(ex[3])}; den = den + 1.f;
                    const f32x4 sg = (f32x4){frcp(den[0]), frcp(den[1]), frcp(den[2]), frcp(den[3])} * (r * r);
                    const f32x4 v = gu * sg;
                    if (n == 0) { w.x = pk2(v[0], v[1]); w.y = pk2(v[2], v[3]); } else { w.z = pk2(v[0], v[1]); w.w = pk2(v[2], v[3]); }
                }
                *(u32x4*)(O + (size_t)row * FF + u.pn * 128 + wc * 32 + 8 * fq) = w;
            }
    }
};

template <int MODE> struct EpiRes {
    static constexpr bool PERM = true, AFTER_DRAIN = false; static constexpr int MB = MODE == 1 ? 1 : 2, NB = 8 / MB;
    float* h; const bf16_t* hin; bf16_t* hb; u64* ssq_out; const u64* ssq_in; const bf16_t* pp; float scale; unsigned char* hl8;
    struct Raw { u32x4 hi; u32x4 lo4; u32x4 pw; u64 sq; };
    __device__ __forceinline__ void load_batch(Raw (&w)[MB][2], int row0, int colb, int b) const {
#pragma unroll
        for (int k = 0; k < MB; ++k) {
            const int it = b * MB + k, row = row0 + (it >> 2) * 128 + (it & 3) * 16;
#pragma unroll
            for (int bj = 0; bj < 2; ++bj) {
                const size_t o = (size_t)row * D + colb + bj * 128;
                w[k][bj].hi = *(const u32x4*)(hin + o); if (bj == 0) w[k][0].lo4 = *(const u32x4*)(hl8 + (size_t)row * D + lo8_pos(colb));
                if (MODE == 1) { w[k][bj].pw = *(const u32x4*)(pp + o); if (bj == 0) w[k][0].sq = ssq_in[row]; }
            }
        }
    }
    __device__ __forceinline__ void operator()(const f32x4 (&acc)[2][2][4][2], const Unit& u, int wr, int wc, int fr_, int fq_) const {
        const int l_ = lane_id_opaque(), fr = l_ & 15, fq = l_ >> 4; (void)fr_; (void)fq_;
        const int row0 = u.pm * 256 + wr * 64 + fr, colb = u.pn * 256 + wc * 32 + 8 * fq;
        Raw w[2][MB][2];
        load_batch(w[0], row0, colb, 0);
#pragma unroll
        for (int b = 0; b < NB; ++b) {
            __builtin_amdgcn_sched_barrier(0);
            if (b + 1 < NB) load_batch(w[(b + 1) & 1], row0, colb, b + 1);
#pragma unroll
            for (int k = 0; k < MB; ++k) {
                const int it = b * MB + k, ai = it >> 2, m = it & 3, row = row0 + ai * 128 + m * 16;
                float r = 0.f;
                if (MODE == 1) r = __builtin_amdgcn_rsqf((float)w[b & 1][k][0].sq * (1.f / (1024.f * SSQ_FX)) + EPS);
                float part = 0.f; u32x4 lo_out;
#pragma unroll
                for (int bj = 0; bj < 2; ++bj) {
                    f32x4 h0, h1; { const u32x4 l4 = w[b & 1][k][0].lo4; u32x2 l2; l2.x = bj ? l4.z : l4.x; l2.y = bj ? l4.w : l4.y; res_dec8(w[b & 1][k][bj].hi, l2, h0, h1); }
                    const f32x4 a0 = acc[ai][bj][m][0], a1 = acc[ai][bj][m][1];
                    if (MODE == 0) { h0 += a0 * scale; h1 += a1 * scale; }
                    else {
                        const u32x4 q = w[b & 1][k][bj].pw;
                        h0[0] += sigmoidf_(a0[0] * r) * bflo(q.x); h0[1] += sigmoidf_(a0[1] * r) * bfhi(q.x);
                        h0[2] += sigmoidf_(a0[2] * r) * bflo(q.y); h0[3] += sigmoidf_(a0[3] * r) * bfhi(q.y);
                        h1[0] += sigmoidf_(a1[0] * r) * bflo(q.z); h1[1] += sigmoidf_(a1[1] * r) * bfhi(q.z);
                        h1[2] += sigmoidf_(a1[2] * r) * bflo(q.w); h1[3] += sigmoidf_(a1[3] * r) * bfhi(q.w);
                    }
                    u32x4 wo; u32x2 wl; res_enc8(h0, h1, wo, wl);
                    const size_t o = (size_t)row * D + colb + bj * 128;
                    *(u32x4*)(hb + o) = wo;
                    if (bj == 0) { lo_out.x = wl.x; lo_out.y = wl.y; } else { lo_out.z = wl.x; lo_out.w = wl.y; *(u32x4*)(hl8 + (size_t)row * D + lo8_pos(colb)) = lo_out; }
                    part += (h0[0] * h0[0] + h0[1] * h0[1]) + (h0[2] * h0[2] + h0[3] * h0[3]) + (h1[0] * h1[0] + h1[1] * h1[1]) + (h1[2] * h1[2] + h1[3] * h1[3]);
                }
                part += __shfl_xor(part, 16); part += __shfl_xor(part, 32);
                if (fq == 0) atomicAdd(ssq_out + row, (u64)(part * SSQ_FX));
            }
        }
    }
};

struct EpiPlain {
    static constexpr bool PERM = true, AFTER_DRAIN = false;
    bf16_t* O;
    __device__ __forceinline__ void operator()(const f32x4 (&acc)[2][2][4][2], const Unit& u, int wr, int wc, int fr_, int fq_) const {
        const int l_ = lane_id_opaque(), fr = l_ & 15, fq = l_ >> 4; (void)fr_; (void)fq_;
        const int row0 = u.pm * 256 + wr * 64 + fr;
#pragma unroll
        for (int ai = 0; ai < 2; ++ai)
#pragma unroll
            for (int m = 0; m < 4; ++m) {
                __builtin_amdgcn_sched_barrier(0); const int row = row0 + ai * 128 + m * 16;
#pragma unroll
                for (int bj = 0; bj < 2; ++bj) {
                    const int col = u.pn * 256 + bj * 128 + wc * 32 + 8 * fq;
                    const f32x4 a0 = acc[ai][bj][m][0], a1 = acc[ai][bj][m][1];
                    u32x4 w; w.x = pk2(a0[0], a0[1]); w.y = pk2(a0[2], a0[3]); w.z = pk2(a1[0], a1[1]); w.w = pk2(a1[2], a1[3]);
                    *(u32x4*)(O + (size_t)row * D + col) = w;
                }
            }
    }
};

struct EpiNull {
    static constexpr bool PERM = true, AFTER_DRAIN = false;
    float* O; int never;
    __device__ __forceinline__ void operator()(const f32x4 (&acc)[2][2][4][2], const Unit& u, int wr, int wc, int fr_, int fq_) const {
        const int l_ = lane_id_opaque(), fr = l_ & 15, fq = l_ >> 4; (void)fr_; (void)fq_;
        if (never) { f32x4 s = {0.f, 0.f, 0.f, 0.f};
#pragma unroll
            for (int ai = 0; ai < 2; ++ai)
#pragma unroll
                for (int bj = 0; bj < 2; ++bj)
#pragma unroll
                    for (int m = 0; m < 4; ++m) s += acc[ai][bj][m][0] + acc[ai][bj][m][1];
            *(f32x4*)(O + (size_t)(u.pm * 256 + wr * 64 + fr) * D + u.pn * 256 + wc * 32 + 8 * fq) = s; }
    }
};
template <int AB> struct EpiQKV {
    static constexpr bool PERM = true, AFTER_DRAIN = false;
    bf16_t* qk; bf16_t* vT; const u64* ssq; const float* ctab; const float* stab; const LAS float* rt;
    __device__ __forceinline__ void operator()(const f32x4 (&acc)[2][2][4][2], const Unit& u, int wr, int wc, int fr_, int fq_) const {
        const int l_ = lane_id_opaque(), fr = l_ & 15, fq = l_ >> 4; (void)fr_; (void)fq_;
        constexpr int LDQ = AB ? LDAB : LDC;
        const int pn = AB ? (int)((0xA98765DC32B410ULL >> (4 * u.pn)) & 15) : u.pn;
        int kind, vrow0 = 0, dsh = 0;
        if (AB) { if (pn == 4) { kind = 2; vrow0 = 0; } else if (pn >= 11) { kind = 2; vrow0 = 256 + (pn - 11) * 256; dsh = 2 * (pn - 11); } else kind = 0; }
        else { if (pn >= 8) { kind = 2; vrow0 = (pn - 8) * 256; } else kind = 1; }
        const int row0 = u.pm * 256 + wr * 64 + fr;
        float rv[2][4];
        if (rt) {
#pragma unroll
            for (int ai = 0; ai < 2; ++ai)
#pragma unroll
                for (int m = 0; m < 4; ++m) rv[ai][m] = rt[(row0 + ai * 128 + m * 16) & 2047];
        } else {
#pragma unroll
            for (int ai = 0; ai < 2; ++ai)
#pragma unroll
                for (int m = 0; m < 4; ++m) rv[ai][m] = __builtin_amdgcn_rsqf((float)ssq[row0 + ai * 128 + m * 16] * (1.f / (1024.f * SSQ_FX)) + EPS);
        }
        if (AB && kind == 0) {
            f32x4 cb[2][2], sb[2][2];
            { const int pos = row0 & (SEQ - 1); const f32x4* cp = (const f32x4*)(ctab + pos * 32 + 8 * fq); const f32x4* sp = (const f32x4*)(stab + pos * 32 + 8 * fq);
              cb[0][0] = cp[0]; cb[0][1] = cp[1]; sb[0][0] = sp[0]; sb[0][1] = sp[1]; }
#pragma unroll
            for (int it = 0; it < 8; ++it) {
                const int ai = it >> 2, m = it & 3, cur = it & 1, nx = cur ^ 1;
                __builtin_amdgcn_sched_barrier(0);
                const int row = row0 + ai * 128 + m * 16;
                if (it < 7) { const int rown = row0 + ((it + 1) >> 2) * 128 + ((it + 1) & 3) * 16, pos = rown & (SEQ - 1);
                    const f32x4* cp = (const f32x4*)(ctab + pos * 32 + 8 * fq); const f32x4* sp = (const f32x4*)(stab + pos * 32 + 8 * fq);
                    cb[nx][0] = cp[0]; cb[nx][1] = cp[1]; sb[nx][0] = sp[0]; sb[nx][1] = sp[1]; }
                const float r = rv[ai][m];
                u32x4 w1, w2;
#pragma unroll
                for (int n = 0; n < 2; ++n) {
                    const f32x4 c4 = cb[cur][n], s4 = sb[cur][n];
                    const f32x4 x1 = acc[ai][0][m][n] * r, x2 = acc[ai][1][m][n] * r;
                    const f32x4 o1 = x1 * c4 - x2 * s4, o2 = x2 * c4 + x1 * s4;
                    if (n == 0) { w1.x = pk2(o1[0], o1[1]); w1.y = pk2(o1[2], o1[3]); w2.x = pk2(o2[0], o2[1]); w2.y = pk2(o2[2], o2[3]); }
                    else { w1.z = pk2(o1[0], o1[1]); w1.w = pk2(o1[2], o1[3]); w2.z = pk2(o2[0], o2[1]); w2.w = pk2(o2[2], o2[3]); }
                }
                bf16_t* op = qk + (size_t)row * LDQ + pn * 256 + wc * 64 + 8 * fq;
                *(u32x4*)op = w1; *(u32x4*)(op + 32) = w2;
            }
            return;
        }
        if (AB && kind == 2 && dsh == 4) {
#pragma unroll
            for (int ai = 0; ai < 2; ++ai) {
                __builtin_amdgcn_sched_barrier(0);
                float rm[4];
#pragma unroll
                for (int m = 0; m < 4; ++m) rm[m] = rv[ai][m];
                const int rowb = u.pm * 256 + wr * 64 + ai * 128, s0 = rowb & (SEQ - 1), b = rowb >> 13;
                const int tidx = b * SEQ + fr * (SEQ >> 4) + (s0 >> 4);
#pragma unroll
                for (int bj = 0; bj < 2; ++bj)
#pragma unroll
                    for (int n = 0; n < 2; ++n)
#pragma unroll
                        for (int i = 0; i < 4; ++i) {
                            const int vr = vrow0 + bj * 128 + wc * 32 + 8 * fq + 4 * n + i;
                            u32x2 w; w.x = pk2(acc[ai][bj][0][n][i] * rm[0], acc[ai][bj][1][n][i] * rm[1]); w.y = pk2(acc[ai][bj][2][n][i] * rm[2], acc[ai][bj][3][n][i] * rm[3]);
                            *(u32x2*)(vT + vt_off(vr >> 6, tidx) + (size_t)(vr & 63) * 64) = w;
                        }
            }
            return;
        }
#pragma unroll
        for (int ai = 0; ai < 2; ++ai)
#pragma unroll
            for (int m = 0; m < 4; ++m) {
                __builtin_amdgcn_sched_barrier(0); const int row = row0 + ai * 128 + m * 16;
                const float r = rv[ai][m];
                if (kind == 0) {
                    const int pos = row & (SEQ - 1);
                    const f32x4* cp = (const f32x4*)(ctab + pos * 32 + 8 * fq); const f32x4* sp = (const f32x4*)(stab + pos * 32 + 8 * fq);
                    u32x4 w1, w2;
#pragma unroll
                    for (int n = 0; n < 2; ++n) {
                        const f32x4 c4 = cp[n], s4 = sp[n];
                        const f32x4 x1 = acc[ai][0][m][n] * r, x2 = acc[ai][1][m][n] * r;
                        const f32x4 o1 = x1 * c4 - x2 * s4, o2 = x2 * c4 + x1 * s4;
                        if (n == 0) { w1.x = pk2(o1[0], o1[1]); w1.y = pk2(o1[2], o1[3]); w2.x = pk2(o2[0], o2[1]); w2.y = pk2(o2[2], o2[3]); }
                        else { w1.z = pk2(o1[0], o1[1]); w1.w = pk2(o1[2], o1[3]); w2.z = pk2(o2[0], o2[1]); w2.w = pk2(o2[2], o2[3]); }
                    }
                    bf16_t* op = qk + (size_t)row * LDQ + pn * 256 + wc * 64 + 8 * fq;
                    *(u32x4*)op = w1; *(u32x4*)(op + 32) = w2;
                } else if (kind == 1) {
#pragma unroll
                    for (int bj = 0; bj < 2; ++bj) {
                        const f32x4 a0 = acc[ai][bj][m][0] * r, a1 = acc[ai][bj][m][1] * r;
                        u32x4 w; w.x = pk2(a0[0], a0[1]); w.y = pk2(a0[2], a0[3]); w.z = pk2(a1[0], a1[1]); w.w = pk2(a1[2], a1[3]);
                        *(u32x4*)(qk + (size_t)row * LDQ + pn * 256 + bj * 128 + wc * 32 + 8 * fq) = w;
                    }
                } else {
                    const int s = row & (SEQ - 1), b = row >> 13;
                    const int tidx = b * SEQ + (s & ((1 << dsh) - 1)) * (SEQ >> dsh) + (s >> dsh);
                    for (int rep = 0; rep < ((MK_DBL & 128) ? 2 : 1); ++rep)
#pragma unroll
                    for (int bj = 0; bj < 2; ++bj)
#pragma unroll
                        for (int n = 0; n < 2; ++n)
#pragma unroll
                            for (int i = 0; i < 4; ++i) {
                                const int vr = vrow0 + bj * 128 + wc * 32 + 8 * fq + 4 * n + i;
                                vT[vt_off(vr >> 6, tidx) + (size_t)(vr & 63) * 64] = (bf16_t)f2bf(acc[ai][bj][m][n][i] * r);
                            }
                }
            }
    }
};

struct PPOrder {
    int c, G, nwg;
    __device__ bool next(int i, Unit& u) const {
        if (G == 256) { if (c < 128 || i >= 2) return false; const int x = c & 7, li = ((c - 128) >> 3) * 2 + i; u.pm = 8 * x + (li >> 2); u.pn = li & 3; return true; }
        const long L = (long)i * G + c; if (L >= nwg) return false; u.pm = (int)L >> 2; u.pn = (int)L & 3; return true;
    }
    __device__ __forceinline__ void a_ready(const Unit&) const {}
    __device__ __forceinline__ void done(const Unit&) const {}
};
#define MFMA32(a, b, c) __builtin_amdgcn_mfma_f32_32x32x16_bf16((a), (b), (c), 0, 0, 0)
__device__ __forceinline__ int crow(int reg, int h) { return (reg & 3) + 8 * (reg >> 2) + 4 * h; }
struct AttnSt { f32x16 o0, o1; float m, l; };

__device__ __forceinline__ void attn_init(AttnSt& st, float m0, float l0) {
#pragma unroll
    for (int i = 0; i < 16; ++i) { st.o0[i] = 0.f; st.o1[i] = 0.f; }
    st.m = m0; st.l = l0;
}
constexpr int KROW_B = 144, VROW_B = 80, KT_BYTES = 32 * KROW_B, WAVE_LDS = 16384;
__device__ __forceinline__ int kperm(int r) { return (r & 0x13) | ((r & 4) << 1) | ((r & 8) >> 1); }
__device__ __forceinline__ int ktok(int i, int hh) { return 16 * (i >> 3) + 8 * hh + 4 * ((i >> 2) & 1) + (i & 3); }
struct KVRaw { u32x4 k[4], v[4]; };
struct KVFrag { bf16x8 kf[4], vf[2][2]; };
__device__ __forceinline__ void kv_gload(KVRaw& w, const bf16_t* kt, size_t kstride, const bf16_t* vt, int lane) {
#pragma unroll
    for (int j = 0; j < 4; ++j) w.k[j] = *(const u32x4*)(kt + (size_t)((lane >> 3) + 8 * j) * kstride + (lane & 7) * 8);
#pragma unroll
    for (int j = 0; j < 4; ++j) w.v[j] = *(const u32x4*)(vt + ((lane >> 2) + 16 * j) * 64 + (lane & 3) * 8);
}
__device__ __forceinline__ void kv_stage(const KVRaw& w, LAS unsigned char* lw, int lane) {
#pragma unroll
    for (int j = 0; j < 4; ++j) *(LAS u32x4*)(lw + ((lane >> 3) + 8 * j) * KROW_B + (lane & 7) * 16) = w.k[j];
#pragma unroll
    for (int j = 0; j < 4; ++j) *(LAS u32x4*)(lw + KT_BYTES + ((lane >> 2) + 16 * j) * VROW_B + (lane & 3) * 16) = w.v[j];
}
__device__ __forceinline__ void kv_frag(KVFrag& f, const LAS unsigned char* lw, int r, int hh) {
    const LAS unsigned char* kp = lw + kperm(r) * KROW_B + 16 * hh;
#pragma unroll
    for (int s = 0; s < 4; ++s) f.kf[s] = *(const LAS bf16x8*)(kp + 32 * s);
#pragma unroll
    for (int db = 0; db < 2; ++db)
#pragma unroll
        for (int s2 = 0; s2 < 2; ++s2) f.vf[db][s2] = *(const LAS bf16x8*)(lw + KT_BYTES + (32 * db + r) * VROW_B + 32 * s2 + 16 * hh);
}
__device__ __forceinline__ float xhalf_max(float v) { const unsigned u = __builtin_bit_cast(unsigned, v); auto r = __builtin_amdgcn_permlane32_swap(u, u, false, false); return fmaxf(__builtin_bit_cast(float, (unsigned)r[0]), __builtin_bit_cast(float, (unsigned)r[1])); }
__device__ __forceinline__ float xhalf_sum(float v) { const unsigned u = __builtin_bit_cast(unsigned, v); auto r = __builtin_amdgcn_permlane32_swap(u, u, false, false); return __builtin_bit_cast(float, (unsigned)r[0]) + __builtin_bit_cast(float, (unsigned)r[1]); }
template <bool HAS_BIAS> __device__ __forceinline__ void attn_tile(AttnSt& st, const bf16x8 (&qf)[4], const KVFrag& f, const f32x16& bias) {
    f32x16 x;
#pragma unroll
    for (int i = 0; i < 16; ++i) x[i] = 0.f;
    __builtin_amdgcn_s_setprio(1);
#pragma unroll
    for (int s = 0; s < 4; ++s) x = MFMA32(f.kf[s], qf[s], x);
    __builtin_amdgcn_s_setprio(0);
    float mx = NEGINF;
#pragma unroll
    for (int i = 0; i < 16; ++i) { x[i] = HAS_BIAS ? x[i] * SC2 + bias[i] : x[i] * SC2; mx = fmaxf(mx, x[i]); }
    mx = xhalf_max(mx);
    const float mn = fmaxf(st.m, mx);
    const float alpha = fexp2(st.m - mn);
    float ls = 0.f;
#pragma unroll
    for (int i = 0; i < 16; ++i) { x[i] = fexp2(x[i] - mn); ls += x[i]; }
    ls = xhalf_sum(ls);
    st.l = st.l * alpha + ls; st.m = mn;
#pragma unroll
    for (int i = 0; i < 16; ++i) { st.o0[i] *= alpha; st.o1[i] *= alpha; }
    u32x4 p0, p1;
    p0.x = pk2(x[0], x[1]); p0.y = pk2(x[2], x[3]); p0.z = pk2(x[4], x[5]); p0.w = pk2(x[6], x[7]);
    p1.x = pk2(x[8], x[9]); p1.y = pk2(x[10], x[11]); p1.z = pk2(x[12], x[13]); p1.w = pk2(x[14], x[15]);
    const bf16x8 pf0 = __builtin_bit_cast(bf16x8, p0), pf1 = __builtin_bit_cast(bf16x8, p1);
    __builtin_amdgcn_s_setprio(1);
    st.o0 = MFMA32(f.vf[0][0], pf0, st.o0); st.o0 = MFMA32(f.vf[0][1], pf1, st.o0);
    st.o1 = MFMA32(f.vf[1][0], pf0, st.o1); st.o1 = MFMA32(f.vf[1][1], pf1, st.o1);
    __builtin_amdgcn_s_setprio(0);
}
template <class KP, class NB, class BF> __device__ __forceinline__ void attn_loop(AttnSt& st, const bf16x8 (&qf)[4], int tlo, int thi, int lane, LAS unsigned char* lw, KP kvp, NB needb, BF biasf, bool dummy = false) {
    const int r = lane & 31, hh = lane >> 5;
    const bf16_t* kt; const bf16_t* vt; size_t ks;
#if MK_PF2
    KVRaw wa, wb;
    if (!dummy) { kvp(tlo, kt, ks, vt); kv_gload(wa, kt, ks, vt, lane);
    kvp(tlo + 1 <= thi ? tlo + 1 : thi, kt, ks, vt); kv_gload(wb, kt, ks, vt, lane); }
    for (int t = tlo; t <= thi; t += 2) {
        { if (!dummy) { kv_stage(wa, lw, lane);
          kvp(t + 2 <= thi ? t + 2 : thi, kt, ks, vt); kv_gload(wa, kt, ks, vt, lane); }
          KVFrag f; kv_frag(f, lw, r, hh);
          f32x16 bias;
          if (needb(t)) { biasf(t, bias); attn_tile<true>(st, qf, f, bias); } else attn_tile<false>(st, qf, f, bias); }
        if (t + 1 <= thi) {
          if (!dummy) { kv_stage(wb, lw, lane);
          kvp(t + 3 <= thi ? t + 3 : thi, kt, ks, vt); kv_gload(wb, kt, ks, vt, lane); }
          KVFrag f; kv_frag(f, lw, r, hh);
          f32x16 bias;
          if (needb(t + 1)) { biasf(t + 1, bias); attn_tile<true>(st, qf, f, bias); } else attn_tile<false>(st, qf, f, bias); }
    }
#else
    KVRaw wa;
    if (!dummy) { kvp(tlo, kt, ks, vt); kv_gload(wa, kt, ks, vt, lane); }
    for (int t = tlo; t <= thi; ++t) {
        if (!dummy) { kv_stage(wa, lw, lane);
          kvp(t + 1 <= thi ? t + 1 : thi, kt, ks, vt); kv_gload(wa, kt, ks, vt, lane); }
        KVFrag f; kv_frag(f, lw, r, hh);
        f32x16 bias;
        if (needb(t)) { biasf(t, bias); attn_tile<true>(st, qf, f, bias); } else attn_tile<false>(st, qf, f, bias);
    }
#endif
}
__device__ __forceinline__ void attn_store(const AttnSt& st, bf16_t* orow, int hh) {
    const float inv = 1.f / st.l;
#pragma unroll
    for (int g = 0; g < 4; g += 2) {
#pragma unroll
        for (int hb = 0; hb < 2; ++hb) {
            const f32x16& o = hb ? st.o1 : st.o0;
            unsigned ax = pk2(o[4 * g] * inv, o[4 * g + 1] * inv), ay = pk2(o[4 * g + 2] * inv, o[4 * g + 3] * inv);
            unsigned bx = pk2(o[4 * g + 4] * inv, o[4 * g + 5] * inv), by = pk2(o[4 * g + 6] * inv, o[4 * g + 7] * inv);
            { auto rx = __builtin_amdgcn_permlane32_swap(ax, bx, false, false); ax = rx[0]; bx = rx[1]; }
            { auto ry = __builtin_amdgcn_permlane32_swap(ay, by, false, false); ay = ry[0]; by = ry[1]; }
            u32x4 w; w.x = ax; w.y = ay; w.z = bx; w.w = by;
            *(u32x4*)(orow + 32 * hb + 8 * (g + hh)) = w;
        }
    }
}
__device__ __forceinline__ void load_q(bf16x8 (&qf)[4], const bf16_t* qrow, int hh) {
#pragma unroll
    for (int s = 0; s < 4; ++s) qf[s] = *(const bf16x8*)(qrow + 16 * s + 8 * hh);
}

__device__ __forceinline__ void attn_a_unit(int unit, const bf16_t* qk, const bf16_t* vT, const float* sink, bf16_t* ao, LAS unsigned char* lw, int lane, bool dummy = false, bool never = false) {
    const int r = lane & 31, hh = lane >> 5;
    const int qt = (unit / 3) & 255, kvh = (unit / 768) & 3, b = unit / 3072, h = kvh * 3 + unit % 3;
    const int q0 = 32 * qt, qrow = b * SEQ + q0 + r;
    bf16x8 qf[4]; load_q(qf, qk + (size_t)qrow * LDAB + h * 64, hh);
    AttnSt st; attn_init(st, sink[h] * LOG2E, 1.f);
    const int tlo = qt - 4 < 0 ? 0 : qt - 4, thi = qt + 4 > 255 ? 255 : qt + 4;
    const bf16_t* kbase = qk + (size_t)(b * SEQ) * LDAB + 768 + kvh * 64;
    attn_loop(st, qf, tlo, thi, lane, lw,
        [&](int t, const bf16_t*& kt, size_t& ks, const bf16_t*& vt) { kt = kbase + (size_t)(32 * t) * LDAB; ks = LDAB; vt = vT + vt_off(kvh, b * SEQ + 32 * t); },
        [&](int t) { return t - qt > 3 || qt - t > 3; },
        [&](int t, f32x16& bias) {
#pragma unroll
            for (int i = 0; i < 16; ++i) { const int dk = (32 * t + ktok(i, hh)) - (q0 + r); bias[i] = (dk <= 128 && dk >= -128) ? 0.f : NEGINF; } }, dummy);
    if (!dummy || never) attn_store(st, ao + (size_t)qrow * D + h * 64, hh);
}
__device__ __forceinline__ void attn_b_unit(int unit, const bf16_t* qk, const bf16_t* vT, bf16_t* obp, float* lse, LAS unsigned char* lw, int lane, bool dummy = false, bool never = false) {
    const int r = lane & 31, hh = lane >> 5;
    const int gi = unit >> 11, idx = unit & 2047, dsh = 2 * gi, d = 1 << dsh, ntile = 256 >> dsh, sub = SEQ >> dsh;
    const int ut = idx % ntile, rr = (idx / ntile) % d, sl = (idx >> 8) & 3, b = idx >> 10, hb = gi * 4 + sl;
    const int u0 = 32 * ut, qrow = b * SEQ + (u0 + r) * d + rr;
    bf16x8 qf[4]; load_q(qf, qk + (size_t)qrow * LDAB + 1280 + hb * 64, hh);
    AttnSt st; attn_init(st, -1e30f, 0.f);
    const int tlo = ut - 2 < 0 ? 0 : ut - 2, thi = ut + 2 > ntile - 1 ? ntile - 1 : ut + 2;
    const bf16_t* kbase = qk + (size_t)(b * SEQ + rr) * LDAB + 2048 + hb * 64;
    const size_t kstr = (size_t)d * LDAB;
    attn_loop(st, qf, tlo, thi, lane, lw,
        [&](int t, const bf16_t*& kt, size_t& ks, const bf16_t*& vt) { kt = kbase + (size_t)(32 * t) * kstr; ks = kstr; vt = vT + vt_off(4 + hb, b * SEQ + rr * sub + 32 * t); },
        [&](int t) { return t - ut > 1 || ut - t > 1; },
        [&](int t, f32x16& bias) {
#pragma unroll
            for (int i = 0; i < 16; ++i) { const int dk = (32 * t + ktok(i, hh)) - (u0 + r); bias[i] = (dk <= 64 && dk >= -64) ? 0.f : NEGINF; } }, dummy);
    if (!dummy || never) attn_store(st, obp + ((size_t)gi * T + qrow) * 256 + sl * 64, hh);
    if (hh == 0 && (!dummy || never)) lse[((size_t)gi * T + qrow) * 4 + sl] = st.m + __builtin_amdgcn_logf(st.l);
}
__device__ __forceinline__ void attn_c_unit(int unit, int& cur_h, const bf16_t* qk, const bf16_t* vT, const float* rpb, bf16_t* ao, LAS unsigned char* lw, int lane, bool dummy = false, bool never = false) {
    LAS float* rp = (LAS float*)(lw + 12288);
    const int r = lane & 31, hh = lane >> 5;
    const int cg = unit & 3, rpair = (unit >> 2) & 63, b = (unit >> 8) & 1, h = unit >> 9;
    if (h != cur_h) { for (int x = lane; x < 465; x += 64) rp[x] = rpb[h * 465 + x] * LOG2E; cur_h = h; }
    const int gi = 2 * rpair + (r >> 4), j = 16 * cg + (r & 15), qrow = b * SEQ + gi * 64 + j;
    int rsq = gi - 4; rsq = rsq < 0 ? 0 : (rsq > 120 ? 120 : rsq);
    int cs = j - 8; cs = cs < 0 ? 0 : (cs > 48 ? 48 : cs);
    int rs0 = 2 * rpair - 4; rs0 = rs0 < 0 ? 0 : (rs0 > 120 ? 120 : rs0);
    int rs1 = 2 * rpair - 3; rs1 = rs1 < 0 ? 0 : (rs1 > 120 ? 120 : rs1);
    const int c0 = cg == 0 ? 0 : (cg == 1 ? 8 : (cg == 2 ? 24 : 32));
    bf16x8 qf[4]; load_q(qf, qk + (size_t)qrow * LDC + h * 64, hh);
    AttnSt st; attn_init(st, -1e30f, 0.f);
    const bf16_t* kbase = qk + (size_t)(b * SEQ + rs0 * 64 + c0) * LDC + 1024 + h * 64;
    attn_loop(st, qf, 0, rs1 - rs0 + 7, lane, lw,
        [&](int t, const bf16_t*& kt, size_t& ks, const bf16_t*& vt) { kt = kbase + (size_t)(64 * t) * LDC; ks = LDC; vt = vT + vt_off(h, b * SEQ + (rs0 + t) * 64 + c0); },
        [&](int) { return true; },
        [&](int t, f32x16& bias) {
            const int kr = rs0 + t; const bool rowok = (kr >= rsq) && (kr < rsq + 8);
            const int rbase = rowok ? (kr - gi + 7) * 31 + (c0 - j + 15) : 0, cb = c0 - cs;
#pragma unroll
            for (int i = 0; i < 16; ++i) { const int kk = ktok(i, hh); const bool ok = rowok && ((unsigned)(cb + kk) < 16u); bias[i] = ok ? rp[ok ? rbase + kk : 0] : NEGINF; } }, dummy);
    if (!dummy || never) attn_store(st, ao + (size_t)qrow * D + h * 64, hh);
}


template <bool HAS_BIAS, class BI> __device__ __forceinline__ void attn_tile2(AttnSt& st, const bf16x8 (&qf)[4], const LAS unsigned char* lw, int r, int hh, BI bias_i) {
    f32x16 x;
#pragma unroll
    for (int i = 0; i < 16; ++i) x[i] = 0.f;
    { const LAS unsigned char* kp = lw + kperm(r) * KROW_B + 16 * hh;
#pragma unroll
      for (int s = 0; s < 4; ++s) x = MFMA32(*(const LAS bf16x8*)(kp + 32 * s), qf[s], x); }
    float mx = NEGINF;
#pragma unroll
    for (int i = 0; i < 16; ++i) { x[i] = HAS_BIAS ? x[i] * SC2 + bias_i(i) : x[i] * SC2; mx = fmaxf(mx, x[i]); }
    mx = xhalf_max(mx);
    const float mn = fmaxf(st.m, mx);
    const float alpha = fexp2(st.m - mn);
    float ls = 0.f;
#pragma unroll
    for (int i = 0; i < 16; ++i) { x[i] = fexp2(x[i] - mn); ls += x[i]; }
    ls = xhalf_sum(ls);
    st.l = st.l * alpha + ls; st.m = mn;
#pragma unroll
    for (int i = 0; i < 16; ++i) { st.o0[i] *= alpha; st.o1[i] *= alpha; }
    u32x4 p0, p1;
    p0.x = pk2(x[0], x[1]); p0.y = pk2(x[2], x[3]); p0.z = pk2(x[4], x[5]); p0.w = pk2(x[6], x[7]);
    p1.x = pk2(x[8], x[9]); p1.y = pk2(x[10], x[11]); p1.z = pk2(x[12], x[13]); p1.w = pk2(x[14], x[15]);
    const bf16x8 pf0 = __builtin_bit_cast(bf16x8, p0), pf1 = __builtin_bit_cast(bf16x8, p1);
    const LAS unsigned char* vp = lw + KT_BYTES + r * VROW_B + 16 * hh;
    st.o0 = MFMA32(*(const LAS bf16x8*)(vp), pf0, st.o0); st.o0 = MFMA32(*(const LAS bf16x8*)(vp + 32), pf1, st.o0);
    st.o1 = MFMA32(*(const LAS bf16x8*)(vp + 32 * VROW_B), pf0, st.o1); st.o1 = MFMA32(*(const LAS bf16x8*)(vp + 32 * VROW_B + 32), pf1, st.o1);
}
template <class KP, class NB, class BF> __device__ __forceinline__ void attn_loop2(AttnSt& s0, AttnSt& s1, const bf16x8 (&q0)[4], const bf16x8 (&q1)[4], int lo0, int hi0, int lo1, int hi1,
                                                                                  int lane, LAS unsigned char* lw, KP kvp, NB needb, BF biasf) {
    const int r = lane & 31, hh = lane >> 5;
    const int tlo = lo0 < lo1 ? lo0 : lo1, thi = hi0 > hi1 ? hi0 : hi1;
    const bf16_t* kt; const bf16_t* vt; size_t ks;
    KVRaw wa;
    kvp(tlo, kt, ks, vt); kv_gload(wa, kt, ks, vt, lane);
    for (int t = tlo; t <= thi; ++t) {
        { const int ln = lane_id_opaque();
          kv_stage(wa, lw, ln);
          kvp(t + 1 <= thi ? t + 1 : thi, kt, ks, vt); kv_gload(wa, kt, ks, vt, ln); }
        if (t >= lo0 && t <= hi0) { auto bi = biasf(0, t); if (needb(0, t)) attn_tile2<true>(s0, q0, lw, r, hh, bi); else attn_tile2<false>(s0, q0, lw, r, hh, bi); }
        if (t >= lo1 && t <= hi1) { auto bi = biasf(1, t); if (needb(1, t)) attn_tile2<true>(s1, q1, lw, r, hh, bi); else attn_tile2<false>(s1, q1, lw, r, hh, bi); }
    }
}
__device__ __forceinline__ void attn_a2_unit(int unit, const bf16_t* qk, const bf16_t* vT, const float* sink, bf16_t* ao, LAS unsigned char* lw, int lane) {
    const int r = lane & 31, hh = lane >> 5;
    const int qtp = unit & 127, h = (unit >> 7) % 12, b = unit / (128 * 12), kvh = h / 3;
    const int qa = 2 * qtp, q0 = 32 * qa, qrow = b * SEQ + q0 + r;
    bf16x8 qf0[4], qf1[4]; load_q(qf0, qk + (size_t)qrow * LDAB + h * 64, hh); load_q(qf1, qk + (size_t)(qrow + 32) * LDAB + h * 64, hh);
    AttnSt s0, s1; attn_init(s0, sink[h] * LOG2E, 1.f); attn_init(s1, sink[h] * LOG2E, 1.f);
    const int lo0 = qa - 4 < 0 ? 0 : qa - 4, hi0 = qa + 4 > 255 ? 255 : qa + 4, lo1 = qa - 3 < 0 ? 0 : qa - 3, hi1 = qa + 5 > 255 ? 255 : qa + 5;
    const bf16_t* kbase = qk + (size_t)(b * SEQ) * LDAB + 768 + kvh * 64;
    attn_loop2(s0, s1, qf0, qf1, lo0, hi0, lo1, hi1, lane, lw,
        [&](int t, const bf16_t*& kt, size_t& ks, const bf16_t*& vt) { kt = kbase + (size_t)(32 * t) * LDAB; ks = LDAB; vt = vT + vt_off(kvh, b * SEQ + 32 * t); },
        [&](int w, int t) { const int dq = t - (qa + w); return dq > 3 || dq < -3; },
        [&](int w, int t) { int base = 32 * t - (q0 + 32 * w + r) + 8 * hh; asm volatile("" : "+v"(base));
            return [base](int i) { const int dk = base + (16 * (i >> 3) + 4 * ((i >> 2) & 1) + (i & 3)); return (dk <= 128 && dk >= -128) ? 0.f : NEGINF; }; });
    attn_store(s0, ao + (size_t)qrow * D + h * 64, hh); attn_store(s1, ao + (size_t)(qrow + 32) * D + h * 64, hh);
}
__device__ __forceinline__ void attn_b2_unit(int unit, const bf16_t* qk, const bf16_t* vT, bf16_t* obp, float* lse, LAS unsigned char* lw, int lane) {
    const int r = lane & 31, hh = lane >> 5;
    const int gi = unit >> 10, idx = unit & 1023, dsh = 2 * gi, d = 1 << dsh, ntile = 256 >> dsh, ntile2 = 128 >> dsh, sub = SEQ >> dsh;
    const int utp = (idx & 127) % ntile2, rr = (idx & 127) / ntile2, sl = (idx >> 7) & 3, b = idx >> 9, hb = gi * 4 + sl;
    const int ua = 2 * utp, u0 = 32 * ua, qrow0 = b * SEQ + (u0 + r) * d + rr, qrow1 = qrow0 + 32 * d;
    bf16x8 qf0[4], qf1[4]; load_q(qf0, qk + (size_t)qrow0 * LDAB + 1280 + hb * 64, hh); load_q(qf1, qk + (size_t)qrow1 * LDAB + 1280 + hb * 64, hh);
    AttnSt s0, s1; attn_init(s0, -1e30f, 0.f); attn_init(s1, -1e30f, 0.f);
    const int lo0 = ua - 2 < 0 ? 0 : ua - 2, hi0 = ua + 2 > ntile - 1 ? ntile - 1 : ua + 2, lo1 = ua - 1 < 0 ? 0 : ua - 1, hi1 = ua + 3 > ntile - 1 ? ntile - 1 : ua + 3;
    const bf16_t* kbase = qk + (size_t)(b * SEQ + rr) * LDAB + 2048 + hb * 64;
    const size_t kstr = (size_t)d * LDAB;
    attn_loop2(s0, s1, qf0, qf1, lo0, hi0, lo1, hi1, lane, lw,
        [&](int t, const bf16_t*& kt, size_t& ks, const bf16_t*& vt) { kt = kbase + (size_t)(32 * t) * kstr; ks = kstr; vt = vT + vt_off(4 + hb, b * SEQ + rr * sub + 32 * t); },
        [&](int w, int t) { const int dq = t - (ua + w); return dq > 1 || dq < -1; },
        [&](int w, int t) { int base = 32 * t - (u0 + 32 * w + r) + 8 * hh; asm volatile("" : "+v"(base));
            return [base](int i) { const int dk = base + (16 * (i >> 3) + 4 * ((i >> 2) & 1) + (i & 3)); return (dk <= 64 && dk >= -64) ? 0.f : NEGINF; }; });
    attn_store(s0, obp + ((size_t)gi * T + qrow0) * 256 + sl * 64, hh); attn_store(s1, obp + ((size_t)gi * T + qrow1) * 256 + sl * 64, hh);
    if (hh == 0) { lse[((size_t)gi * T + qrow0) * 4 + sl] = s0.m + __builtin_amdgcn_logf(s0.l); lse[((size_t)gi * T + qrow1) * 4 + sl] = s1.m + __builtin_amdgcn_logf(s1.l); }
}
__device__ __forceinline__ void attn_c2_unit(int unit, int& cur_h, const bf16_t* qk, const bf16_t* vT, const float* rpb, bf16_t* ao, LAS unsigned char* lw, int lane) {
    LAS float* rp = (LAS float*)(lw + 12288);
    const int r = lane & 31, hh = lane >> 5;
    const int cg = unit & 3, P = (unit >> 2) & 31, b = (unit >> 7) & 1, h = unit >> 8;
    if (h != cur_h) { for (int x = lane; x < 465; x += 64) rp[x] = rpb[h * 465 + x] * LOG2E; cur_h = h; }
    const int j = 16 * cg + (r & 15), gi0 = 4 * P + (r >> 4), qrow0 = b * SEQ + gi0 * 64 + j, qrow1 = qrow0 + 128;
    auto clampr = [](int x) { return x < 0 ? 0 : (x > 120 ? 120 : x); };
    const int rs0 = clampr(4 * P - 4);
    const int lo0 = 0, hi0 = clampr(4 * P - 3) + 7 - rs0, lo1 = clampr(4 * P - 2) - rs0, hi1 = clampr(4 * P - 1) + 7 - rs0;
    const int c0 = cg == 0 ? 0 : (cg == 1 ? 8 : (cg == 2 ? 24 : 32));
    bf16x8 qf0[4], qf1[4]; load_q(qf0, qk + (size_t)qrow0 * LDC + h * 64, hh); load_q(qf1, qk + (size_t)qrow1 * LDC + h * 64, hh);
    AttnSt s0, s1; attn_init(s0, -1e30f, 0.f); attn_init(s1, -1e30f, 0.f);
    const bf16_t* kbase = qk + (size_t)(b * SEQ + rs0 * 64 + c0) * LDC + 1024 + h * 64;
    attn_loop2(s0, s1, qf0, qf1, lo0, hi0, lo1, hi1, lane, lw,
        [&](int t, const bf16_t*& kt, size_t& ks, const bf16_t*& vt) { kt = kbase + (size_t)(64 * t) * LDC; ks = LDC; vt = vT + vt_off(h, b * SEQ + (rs0 + t) * 64 + c0); },
        [&](int, int) { return true; },
        [&](int w, int t) {
            const int kr = rs0 + t, gq = gi0 + 2 * w, rsq = clampr(gq - 4); const bool rowok = (kr >= rsq) && (kr < rsq + 8);
            int cs = j - 8; cs = cs < 0 ? 0 : (cs > 48 ? 48 : cs);
            int rb = (rowok ? (kr - gq + 7) * 31 + (c0 - j + 15) : 0) + 8 * hh, cbb = (rowok ? c0 - cs : 1000) + 8 * hh; asm volatile("" : "+v"(rb), "+v"(cbb));
            return [rb, cbb, rp](int i) { const int kk0 = 16 * (i >> 3) + 4 * ((i >> 2) & 1) + (i & 3); const bool ok = (unsigned)(cbb + kk0) < 16u; return ok ? rp[ok ? rb + kk0 : 0] : NEGINF; }; });
    { const int l2 = lane_id_opaque(), r2 = l2 & 31, hh2 = l2 >> 5;
      const size_t q0r = (size_t)(b * SEQ + (4 * P + (r2 >> 4)) * 64 + 16 * cg + (r2 & 15));
      attn_store(s0, ao + q0r * D + h * 64, hh2); attn_store(s1, ao + (q0r + 128) * D + h * 64, hh2); }
}

__device__ __forceinline__ int dest_row(int mode, int n) {
    if (mode == 1) return 256 * (n >> 7) + (n & 127);
    if (mode == 2) return 256 * (n >> 7) + 128 + (n & 127);
    if (mode == 3) {
        const int base = (int)((0x763DCBA9825410ULL >> (4 * (n >> 8))) & 15) * 256;
        if (n < 1024 || (n >= 1280 && n < 2816)) { const int d = n & 63; return base + (d >> 5) * 128 + ((n >> 6) & 3) * 32 + (d & 31); }
        return base + (n & 255);
    }
    return n;
}
__device__ __forceinline__ void tr_item(const float* W, int K, int N, const float* gain, bf16_t* WT, int mode, LAS float* scr, int item, int lane) {
    const int nblk = N / 32, kb = item / nblk, nb = item % nblk, k0 = 64 * kb, n0 = 32 * nb;
    float wv[32];
#pragma unroll
    for (int i = 0; i < 32; ++i) wv[i] = __builtin_nontemporal_load(W + (size_t)(k0 + 2 * i + (lane >> 5)) * N + n0 + (lane & 31));
#pragma unroll
    for (int i = 0; i < 32; ++i) scr[(2 * i + (lane >> 5)) * 33 + (lane & 31)] = wv[i];
    asm volatile("s_waitcnt lgkmcnt(0)" ::: "memory");
    const int c = lane & 7;
    f32x4 g0 = {1.f, 1.f, 1.f, 1.f}, g1 = g0;
    if (gain) { g0 = *(const f32x4*)(gain + k0 + 8 * c); g1 = *(const f32x4*)(gain + k0 + 8 * c + 4); }
#pragma unroll
    for (int jj = 0; jj < 4; ++jj) {
        const int n = (lane >> 3) + 8 * jj; const LAS float* s = scr + (8 * c) * 33 + n;
        u32x4 o; o.x = pk2(s[0 * 33] * g0[0], s[1 * 33] * g0[1]); o.y = pk2(s[2 * 33] * g0[2], s[3 * 33] * g0[3]);
        o.z = pk2(s[4 * 33] * g1[0], s[5 * 33] * g1[1]); o.w = pk2(s[6 * 33] * g1[2], s[7 * 33] * g1[3]);
        *(u32x4*)(WT + (size_t)dest_row(mode, n0 + n) * K + k0 + 8 * c) = o;
    }
    asm volatile("s_waitcnt lgkmcnt(0)" ::: "memory");
}

#define XB_TMO      128
#define XB_XCNT(j)  (256  + 64 * (j))
#define XB_XSUB(j)  (1280 + 64 * (j))
#define XB_XGEN(j)  (2304 + 64 * (j))
#define XB_TOP      3328
#define XB_TOPGEN   3392
#define XCD_BAR_WORDS 3456
#define XB_SPIN_CAP (1u << 18)

__device__ __forceinline__ unsigned xb_ld(unsigned* p)              { return __hip_atomic_load(p, __ATOMIC_RELAXED, __HIP_MEMORY_SCOPE_AGENT); }
__device__ __forceinline__ unsigned xb_add(unsigned* p, unsigned v) { return __hip_atomic_fetch_add(p, v, __ATOMIC_RELAXED, __HIP_MEMORY_SCOPE_AGENT); }
__device__ __forceinline__ unsigned xb_xcc_id() { return (unsigned)__builtin_amdgcn_s_getreg((3 << 11) | 20) & 0xFu; }
#define XB_SPIN(cond, bar) do { unsigned _sp = 0; while (cond) { __builtin_amdgcn_s_sleep(1); \
    if ((++_sp & 255u) == 0u) { if (xb_ld(&(bar)[XB_TMO])) break; if (_sp > XB_SPIN_CAP) { atomicAdd(&(bar)[XB_TMO], 1u); break; } } } } while (0)

struct XcdBarrier {
    unsigned* bar; unsigned x;
    volatile LAS unsigned* st;
};

__device__ __forceinline__ XcdBarrier xcd_barrier_post(unsigned* bar, volatile LAS unsigned* st) {
    XcdBarrier b; b.bar = bar; b.x = xb_xcc_id(); b.st = st;
    if (threadIdx.x == 0) st[8] = xb_add(&bar[XB_XCNT(b.x)], 1u);
    return b;
}
__device__ __forceinline__ void xcd_barrier_complete(unsigned* bar, unsigned x, unsigned& nloc, unsigned& nx) {
    const unsigned G = gridDim.x * gridDim.y * gridDim.z;
    unsigned sum, cnt, mine, sp = 0u;
    for (;;) {
        sum = 0u; cnt = 0u; mine = 0u;
#pragma unroll
        for (unsigned j = 0; j < 16; ++j) { const unsigned c = xb_ld(&bar[XB_XCNT(j)]); sum += c; cnt += (c > 0u) ? 1u : 0u; mine = (j == x) ? c : mine; }
        if (sum == G) break;
        __builtin_amdgcn_s_sleep(1);
        if ((++sp & 255u) == 0u) { if (xb_ld(&bar[XB_TMO])) break; if (sp > XB_SPIN_CAP) { atomicAdd(&bar[XB_TMO], 1u); break; } }
    }
    nloc = mine > 0u ? mine : 1u; nx = cnt > 0u ? cnt : 1u;
}

__device__ __forceinline__ void xcd_barrier(const XcdBarrier& b, int tid) {
    asm volatile("s_waitcnt vmcnt(0)" ::: "memory");
    __syncthreads();
    if (tid == 0) {
        unsigned* bar = b.bar;
        __builtin_amdgcn_s_waitcnt(0);
        unsigned nloc = b.st[0], nx = b.st[1];
        if (nloc == 0u) { xcd_barrier_complete(bar, b.x, nloc, nx); b.st[0] = nloc; b.st[1] = nx; }
        const unsigned old = xb_add(&bar[XB_XSUB(b.x)], 1u);
        const unsigned gen = old / nloc;
        if (old + 1u == (gen + 1u) * nloc) {
            __builtin_amdgcn_fence(__ATOMIC_RELEASE, "agent");
            asm volatile("s_waitcnt vmcnt(0)" ::: "memory");
            const unsigned og = xb_add(&bar[XB_TOP], 1u);
            const unsigned tg = og / nx;
            if (og + 1u == (tg + 1u) * nx) xb_add(&bar[XB_TOPGEN], 1u);
            else XB_SPIN(xb_ld(&bar[XB_TOPGEN]) == tg, bar);
            __builtin_amdgcn_fence(__ATOMIC_ACQUIRE, "agent");
            xb_add(&bar[XB_XGEN(b.x)], 1u);
            asm volatile("s_waitcnt vmcnt(0)" ::: "memory");
        } else {
            XB_SPIN(xb_ld(&bar[XB_XGEN(b.x)]) == gen, bar);
            __builtin_amdgcn_fence(__ATOMIC_ACQUIRE, "agent");
            asm volatile("s_waitcnt vmcnt(0)" ::: "memory");
        }
    }
    __syncthreads();
}


#define LB_SUB(j) (4096 + 64 * (j))
#define LB_GEN(j) (5120 + 64 * (j))
#define LB_BAD 6400
__device__ __forceinline__ void xcc_local_barrier(const XcdBarrier& b, int tid) {
    asm volatile("s_waitcnt vmcnt(0)" ::: "memory");
    __syncthreads();
    if (tid == 0) {
        unsigned* bar = b.bar; const unsigned nloc = b.st[0];
        const unsigned old = xb_add(&bar[LB_SUB(b.x)], 1u), gen = old / nloc;
        if (old + 1u == (gen + 1u) * nloc) xb_add(&bar[LB_GEN(b.x)], 1u);
        else XB_SPIN(xb_ld(&bar[LB_GEN(b.x)]) == gen, bar);
        __builtin_amdgcn_fence(__ATOMIC_ACQUIRE, "agent");
        asm volatile("s_waitcnt vmcnt(0)" ::: "memory");
    }
    __syncthreads();
}
struct Args {
    const float* in[21]; float* out; unsigned char* ws; int ph_lo, ph_hi;
};

__global__ void __launch_bounds__(NWAVES * 64, 2) mk_fwd(Args args) {
    extern __shared__ __attribute__((aligned(16))) unsigned char lds_raw[];
    LAS unsigned char* lds = (LAS unsigned char*)lds_raw;
    cg::grid_group grid = cg::this_grid();
    const int wave = __builtin_amdgcn_readfirstlane((int)threadIdx.x >> 6);
    const int G = gridDim.x, gw = blockIdx.x * NWAVES + wave, NGW = G * NWAVES, NGT = G * NWAVES * 64;
    unsigned char* ws = args.ws;
    if (threadIdx.x < 16) ((LAS unsigned*)(lds + 131072))[threadIdx.x] = 0u;
    __syncthreads();
    if (args.ph_hi - args.ph_lo > 1) {
        if (blockIdx.x == 0) { for (int w = threadIdx.x; w < 8192; w += NWAVES * 64) ((unsigned*)ws)[w] = 0u; __threadfence(); }
        grid.sync();
    }
    const XcdBarrier xbar = xcd_barrier_post((unsigned*)ws, (volatile LAS unsigned*)(lds + 131072));
    bool fastmap = false; int cvirt = (int)blockIdx.x; int gwa = gw;
    const float* x = args.in[0]; const float* p_in = args.in[1];
    const float* norm_ffn1 = args.in[2]; const float* f1g = args.in[3]; const float* f1u = args.in[4]; const float* f1d = args.in[5];
    const float* norm_mix = args.in[6]; const float* w_in_ab = args.in[7]; const float* sink_a = args.in[8]; const float* w_out_ab = args.in[9];
    const float* w_in_c = args.in[10]; const float* rpb_c = args.in[11]; const float* w_out_c = args.in[12];
    const float* norm_ffn2 = args.in[13]; const float* f2g = args.in[14]; const float* f2u = args.in[15]; const float* f2d = args.in[16];
    const float* norm_ple = args.in[17]; const float* w_pg = args.in[18]; const float* w_pp = args.in[19]; const float* norm_final = args.in[20];
    float* h = args.out;
    u64* ssq = (u64*)(ws + WS_SSQP); float* ctab = (float*)(ws + WS_COS); float* stab = (float*)(ws + WS_SIN); float* lse = (float*)(ws + WS_LSE);
    bf16_t* Wb = (bf16_t*)(ws + WS_W); bf16_t* hb = (bf16_t*)(ws + WS_HB); bf16_t* act = (bf16_t*)(ws + WS_ACT); bf16_t* qk = act;
    bf16_t* vT = (bf16_t*)(ws + WS_VT); bf16_t* hb_alt = vT; bf16_t* ao = (bf16_t*)(ws + WS_AO); bf16_t* ppb = ao; bf16_t* obp = (bf16_t*)(ws + WS_OBP); bf16_t* pb = (bf16_t*)(ws + WS_PB); unsigned char* hl8 = ws + WS_HL8;
    const int lo = args.ph_lo, hi = args.ph_hi;
    const bool fastbar = MK_LOCALBAR && fastmap;
    constexpr int I_GU = 16 * 88, I_DN = 44 * 32, I_IN = 16 * 112, I_INC = 16 * 96, I_SQ = 16 * 32, I_PP = 4 * 32;
    constexpr int L_ITEMS = 6 * I_GU   + I_IN + 2 * I_SQ + I_PP;
    static_assert(I_GU == I_DN, "items");
    auto convert_items = [&](int first, int step, int it_end, int lane) {
        LAS float* scr = (LAS float*)(lds + wave * 16384);
        for (int it = first; it < it_end; it += step) {
            const int li = it / L_ITEMS; int r = it % L_ITEMS; const int j = li >> 1;
            bf16_t* Wl = Wb + (size_t)li * LAYER_W;
            const size_t fo = (size_t)li * D * FF;
            if (r < I_GU) { tr_item(f1g + fo, D, FF, norm_ffn1 + li * D, Wl + O_GU1, 1, scr, r, lane); continue; } r -= I_GU;
            if (r < I_GU) { tr_item(f1u + fo, D, FF, norm_ffn1 + li * D, Wl + O_GU1, 2, scr, r, lane); continue; } r -= I_GU;
            if (r < I_DN) { tr_item(f1d + fo, FF, D, nullptr, Wl + O_D1, 0, scr, r, lane); continue; } r -= I_DN;
            if (r < I_GU) { tr_item(f2g + fo, D, FF, norm_ffn2 + li * D, Wl + O_GU2, 1, scr, r, lane); continue; } r -= I_GU;
            if (r < I_GU) { tr_item(f2u + fo, D, FF, norm_ffn2 + li * D, Wl + O_GU2, 2, scr, r, lane); continue; } r -= I_GU;
            if (r < I_DN) { tr_item(f2d + fo, FF, D, nullptr, Wl + O_D2, 0, scr, r, lane); continue; } r -= I_DN;
            if (r < I_IN) {
                if ((li & 1) == 0) tr_item(w_in_ab + (size_t)j * D * NAB, D, NAB, norm_mix + li * D, Wl + O_IN, 3, scr, r, lane);
                else if (r < I_INC) tr_item(w_in_c + (size_t)j * D * NC, D, NC, norm_mix + li * D, Wl + O_IN, 0, scr, r, lane);
                continue; } r -= I_IN;
            if (r < I_SQ) { tr_item(((li & 1) == 0 ? w_out_ab : w_out_c) + (size_t)j * D * D, D, D, nullptr, Wl + O_OUT, 0, scr, r, lane); continue; } r -= I_SQ;
            if (r < I_SQ) { tr_item(w_pg + (size_t)li * D * D, D, D, norm_ple + li * D, Wl + O_PG, 0, scr, r, lane); continue; } r -= I_SQ;
            tr_item(w_pp + (size_t)li * PLE * D, PLE, D, nullptr, Wl + O_PP, 0, scr, r, lane);
        }
    };
    auto rt_fill = [&](const u64* sqp, int tid) -> const LAS float* {
        if (!fastmap) return nullptr;
        LAS float* rt = (LAS float*)(lds + RT_OFF);
#pragma unroll
        for (int k = 0; k < 4; ++k) { const int t = tid + k * (NWAVES * 64); rt[t] = __builtin_amdgcn_rsqf((float)sqp[(size_t)(cvirt & 7) * 2048 + t] * (1.f / (1024.f * SSQ_FX)) + EPS); }
        __syncthreads();
        return rt;
    };
#define RT_FILL(p) rt_fill((p), tid)
    int pc = 0;
#define PHASE_BEGIN if (pc >= lo && pc < hi) { const int lane = lane_id_opaque(); const int tid = wave * 64 + lane; const int gtid = blockIdx.x * (NWAVES * 64) + tid; (void)gtid;
#define PHASE_END   if (pc + 1 < hi) { xcd_barrier(xbar, wave * 64 + lane_id_opaque()); } } ++pc;
#define PHASE_END_L if (pc + 1 < hi) { if (fastbar) xcc_local_barrier(xbar, wave * 64 + lane_id_opaque()); else { xcd_barrier(xbar, wave * 64 + lane_id_opaque()); if (MK_DBL & 1024) xcd_barrier(xbar, wave * 64 + lane_id_opaque()); } } } ++pc;

    PHASE_BEGIN
    for (int rep = 0; rep < ((MK_DBL & 1) ? 2 : 1); ++rep) {
        convert_items(gw, NGW, (MK_LATECONV ? 1 : DEPTH) * L_ITEMS, lane);
        for (int m = gw; m < T; m += NGW) {
            const f32x4* xr = (const f32x4*)(x + (size_t)m * D) + lane; f32x4* hr = (f32x4*)(h + (size_t)m * D) + lane; u32x2* br = (u32x2*)(hb + (size_t)m * D) + lane;
            float s = 0.f;
#pragma unroll
            for (int q = 0; q < 4; ++q) { const f32x4 v = xr[64 * q]; if (!MK_BF16RES) hr[64 * q] = v; u32x2 w; w.x = pk2(v[0], v[1]); w.y = pk2(v[2], v[3]); br[64 * q] = w;
                if (MK_BF16RES == 2) *(unsigned*)(hl8 + (size_t)m * D + lo8_pos(4 * (lane + 64 * q))) = lo8_enc(v[0], bflo(w.x)) | (lo8_enc(v[1], bfhi(w.x)) << 8) | (lo8_enc(v[2], bflo(w.y)) << 16) | (lo8_enc(v[3], bfhi(w.y)) << 24); s += (v[0] * v[0] + v[1] * v[1]) + (v[2] * v[2] + v[3] * v[3]); }
            s = wave_sum(s);
            if (lane == 0) ssq[m] = (u64)(s * SSQ_FX);
        }
        for (int i = gtid; i < 16 * T; i += NGT) ssq[T + i] = 0ull;
        {
        }
        for (int i0 = gtid; i0 < DEPTH * T * PLE / 8; i0 += 4 * NGT) {
            f32x4 a[4], c[4];
#pragma unroll
            for (int k = 0; k < 4; ++k) { const int i = i0 + k * NGT; if (i < DEPTH * T * PLE / 8) { a[k] = __builtin_nontemporal_load((const f32x4*)p_in + 2 * i); c[k] = __builtin_nontemporal_load((const f32x4*)p_in + 2 * i + 1); } }
#pragma unroll
            for (int k = 0; k < 4; ++k) { const int i = i0 + k * NGT; if (i < DEPTH * T * PLE / 8) {
                u32x4 w; w.x = pk2(a[k][0], a[k][1]); w.y = pk2(a[k][2], a[k][3]); w.z = pk2(c[k][0], c[k][1]); w.w = pk2(c[k][2], c[k][3]);
                ((u32x4*)pb)[i] = w; } }
        }
        for (int i = gtid; i < SEQ * 32; i += NGT) {
            const int pos = i >> 5, dd = i & 31;
            const float inv = exp2f(-(float)dd * (13.287712379549449f / 32.f));
            const float ang = (float)pos * inv;
            double rev = (double)ang * 0.15915494309189535; rev -= __builtin_rint(rev);
            const float rv = (float)rev;
            ctab[i] = __builtin_amdgcn_cosf(rv); stab[i] = __builtin_amdgcn_sinf(rv);
        }
    }
    PHASE_END
    if (lo == 0 && hi > 1) {
        if (wave == 0 && lane_id_opaque() == 0) {
            unsigned ok = gridDim.x == 256 && xbar.x < 8u;
            for (unsigned jx = 0; jx < 16; ++jx) { const unsigned cnt = xb_ld((unsigned*)ws + XB_XCNT(jx)); ok = ok && (cnt == (jx < 8 ? 32u : 0u)); }
            ((volatile LAS unsigned*)(lds + 131072))[9] = ok;
        }
        __syncthreads();
        fastmap = __builtin_amdgcn_readfirstlane((int)((volatile LAS unsigned*)(lds + 131072))[9]) != 0;
        if (fastmap) { cvirt = __builtin_amdgcn_readfirstlane((int)(((volatile LAS unsigned*)(lds + 131072))[8] * 8u + xbar.x)); gwa = ((cvirt & 7) * 32 + (cvirt >> 3)) * NWAVES + wave; }
    }

#pragma unroll 1
    for (int li = 0; li < DEPTH; ++li) {
        const bf16_t* Wl = Wb + (size_t)li * LAYER_W;
        const int j = li >> 1;
        u64* sq = ssq + (size_t)(4 * li) * T;
        PHASE_BEGIN
        for (int rep = 0; rep < ((MK_DBL & 4) ? 2 : 1); ++rep)
        { pg8::Gemm g{li == 0 ? hb : hb_alt, Wl + O_GU1, T, NGU, D}; pg8::StaticOrder S; S.init(T, NGU, G, cvirt);
          EpiGateUp E{act, sq, RT_FILL(sq)};
          pg8::gemm_phase<EpiGateUp, pg8::StaticOrder, true, true>(lds, g, S, E, tid); }
        if (MK_LATECONV && li + 1 < DEPTH) {
            const int ln = lane_id_opaque();
            if (G == 256) { if (cvirt >= 128) convert_items((li + 1) * L_ITEMS + (cvirt - 128) * NWAVES + wave, 128 * NWAVES, (li + 2) * L_ITEMS, ln); }
            else convert_items((li + 1) * L_ITEMS + gw, NGW, (li + 2) * L_ITEMS, ln);
        }
        PHASE_END_L
        PHASE_BEGIN
        if (MK_DBL & 64) { pg8::Gemm g{act, Wl + O_D1, T, D, FF}; pg8::StaticOrder S; S.init(T, D, G, cvirt); EpiRes<0> E{h, hb, hb, (u64*)obp, nullptr, nullptr, 0.0f, hl8}; pg8::gemm_phase<EpiRes<0>, pg8::StaticOrder, true, true>(lds, g, S, E, tid); }
        if (MK_DBL & 16) { pg8::Gemm g{act, Wl + O_D1, T, D, FF}; pg8::StaticOrder S; S.init(T, D, G, cvirt); EpiNull E{h, lo < 0}; pg8::gemm_phase<EpiNull, pg8::StaticOrder, false, true>(lds, g, S, E, tid); }
        { pg8::Gemm g{act, Wl + O_D1, T, D, FF}; pg8::StaticOrder S; S.init(T, D, G, cvirt);
          EpiRes<0> E{h, li == 0 ? hb : hb_alt, hb, sq + 1 * T, nullptr, nullptr, 0.5f, hl8};
          pg8::gemm_phase<EpiRes<0>, pg8::StaticOrder, true, true>(lds, g, S, E, tid); }
        PHASE_END
        if ((li & 1) == 0) {
            PHASE_BEGIN
            for (int rep = 0; rep < ((MK_DBL & 8) ? 2 : 1); ++rep)
            { pg8::Gemm g{hb, Wl + O_IN, T, NAB, D}; pg8::StaticOrder S; S.init(T, NAB, G, cvirt);
              EpiQKV<1> E{qk, vT, sq + 1 * T, ctab, stab, RT_FILL(sq + 1 * T)};
              pg8::gemm_phase<EpiQKV<1>, pg8::StaticOrder, true, true>(lds, g, S, E, tid); }
            PHASE_END
            PHASE_BEGIN
#if MK_NQ2
            for (int u2 = gwa; u2 < ((MK_DBL & 2) ? 2 : 1) * 6144; u2 += NGW) { const int unit = u2 >= 6144 ? u2 - 6144 : u2;
                if (unit < 3072) attn_a2_unit(unit, qk, vT, sink_a + j * 12, ao, lds + wave * WAVE_LDS, lane);
                else attn_b2_unit(unit - 3072, qk, vT, obp, lse, lds + wave * WAVE_LDS, lane);
            }
#else
            for (int u2 = gwa; u2 < ((MK_DBL & 2) ? 2 : 1) * 12288; u2 += NGW) { const int unit = u2 >= 12288 ? u2 - 12288 : u2;
                if (unit < 6144) attn_a_unit(unit, qk, vT, sink_a + j * 12, ao, lds + wave * WAVE_LDS, lane);
                else attn_b_unit(unit - 6144, qk, vT, obp, lse, lds + wave * WAVE_LDS, lane);
            }
#endif
            PHASE_END
            PHASE_BEGIN
            for (int i0 = gtid; i0 < T * 32; i0 += 2 * NGT) {
                const int iA = i0, iB = i0 + NGT; const bool hasB = iB < T * 32;
                const int rowA = iA >> 5, cA = (iA & 31) * 8, slA = cA >> 6, rowB = hasB ? iB >> 5 : rowA, cB = hasB ? (iB & 31) * 8 : cA, slB = cB >> 6;
                const float a0 = lse[(size_t)rowA * 4 + slA], a1 = lse[((size_t)T + rowA) * 4 + slA], a2 = lse[((size_t)2 * T + rowA) * 4 + slA];
                const float b0 = lse[(size_t)rowB * 4 + slB], b1 = lse[((size_t)T + rowB) * 4 + slB], b2 = lse[((size_t)2 * T + rowB) * 4 + slB];
                const u32x4 pa0 = *(const u32x4*)(obp + (size_t)rowA * 256 + cA), pa1 = *(const u32x4*)(obp + ((size_t)T + rowA) * 256 + cA), pa2 = *(const u32x4*)(obp + ((size_t)2 * T + rowA) * 256 + cA);
                const u32x4 pb0 = *(const u32x4*)(obp + (size_t)rowB * 256 + cB), pb1 = *(const u32x4*)(obp + ((size_t)T + rowB) * 256 + cB), pb2 = *(const u32x4*)(obp + ((size_t)2 * T + rowB) * 256 + cB);
                auto mrg = [&](float l0, float l1, float l2, const u32x4& a, const u32x4& bq, const u32x4& c, int row, int c8) {
                    const float mx = fmaxf(l0, fmaxf(l1, l2));
                    float w0 = fexp2(l0 - mx), w1 = fexp2(l1 - mx), w2 = fexp2(l2 - mx);
                    const float inv = 1.f / (w0 + w1 + w2); w0 *= inv; w1 *= inv; w2 *= inv;
                    u32x4 o;
                    o.x = pk2(w0 * bflo(a.x) + w1 * bflo(bq.x) + w2 * bflo(c.x), w0 * bfhi(a.x) + w1 * bfhi(bq.x) + w2 * bfhi(c.x));
                    o.y = pk2(w0 * bflo(a.y) + w1 * bflo(bq.y) + w2 * bflo(c.y), w0 * bfhi(a.y) + w1 * bfhi(bq.y) + w2 * bfhi(c.y));
                    o.z = pk2(w0 * bflo(a.z) + w1 * bflo(bq.z) + w2 * bflo(c.z), w0 * bfhi(a.z) + w1 * bfhi(bq.z) + w2 * bfhi(c.z));
                    o.w = pk2(w0 * bflo(a.w) + w1 * bflo(bq.w) + w2 * bflo(c.w), w0 * bfhi(a.w) + w1 * bfhi(bq.w) + w2 * bfhi(c.w));
                    *(u32x4*)(ao + (size_t)row * D + 768 + c8) = o; };
                mrg(a0, a1, a2, pa0, pa1, pa2, rowA, cA);
                if (hasB) mrg(b0, b1, b2, pb0, pb1, pb2, rowB, cB);
            }
            PHASE_END
        } else {
            PHASE_BEGIN
            for (int rep = 0; rep < ((MK_DBL & 8) ? 2 : 1); ++rep)
            { pg8::Gemm g{hb, Wl + O_IN, T, NC, D}; pg8::StaticOrder S; S.init(T, NC, G, cvirt);
              EpiQKV<0> E{qk, vT, sq + 1 * T, ctab, stab, RT_FILL(sq + 1 * T)};
              pg8::gemm_phase<EpiQKV<0>, pg8::StaticOrder, true, true>(lds, g, S, E, tid); }
            PHASE_END
            PHASE_BEGIN
            {
              int cur_h = -1;
              for (int u2 = gwa; u2 < ((MK_DBL & 2) ? 2 : 1) * 8192; u2 += NGW)
                  attn_c_unit((u2 & 127) | (((u2 >> 11) & 3) << 7) | (((u2 >> 7) & 15) << 9), cur_h, qk, vT, rpb_c + (size_t)j * 16 * 465, ao, lds + wave * WAVE_LDS, lane); }
            PHASE_END
        }
        PHASE_BEGIN
        if (MK_DBL & 32) { pg8::Gemm g{ao, Wl + O_OUT, T, D, D}; pg8::StaticOrder S; S.init(T, D, G, cvirt); EpiNull E{h, lo < 0}; pg8::gemm_phase<EpiNull, pg8::StaticOrder, false, true>(lds, g, S, E, tid); }
        { pg8::Gemm g{ao, Wl + O_OUT, T, D, D}; pg8::StaticOrder S; S.init(T, D, G, cvirt);
          EpiRes<0> E{h, hb, hb, sq + 2 * T, nullptr, nullptr, 1.0f, hl8};
          pg8::gemm_phase<EpiRes<0>, pg8::StaticOrder, true, true>(lds, g, S, E, tid); }
        PHASE_END_L
        PHASE_BEGIN
        for (int rep = 0; rep < ((MK_DBL & 4) ? 2 : 1); ++rep)
        { pg8::Gemm g{hb, Wl + O_GU2, T, NGU, D}; pg8::StaticOrder S; S.init(T, NGU, G, cvirt);
          EpiGateUp E{act, sq + 2 * T, RT_FILL(sq + 2 * T)};
          pg8::gemm_phase<EpiGateUp, pg8::StaticOrder, true, true>(lds, g, S, E, tid); }
        { pg8::Gemm g{pb + (size_t)li * T * PLE, Wl + O_PP, T, D, PLE}; PPOrder S{cvirt, G, 256};
          EpiPlain E{ppb};
          pg8::gemm_phase<EpiPlain, PPOrder, true, true>(lds, g, S, E, tid); }
        PHASE_END_L
        PHASE_BEGIN
        if (MK_DBL & 64) { pg8::Gemm g{act, Wl + O_D2, T, D, FF}; pg8::StaticOrder S; S.init(T, D, G, cvirt); EpiRes<0> E{h, hb, hb, (u64*)obp, nullptr, nullptr, 0.0f, hl8}; pg8::gemm_phase<EpiRes<0>, pg8::StaticOrder, true, true>(lds, g, S, E, tid); }
        if (MK_DBL & 16) { pg8::Gemm g{act, Wl + O_D2, T, D, FF}; pg8::StaticOrder S; S.init(T, D, G, cvirt); EpiNull E{h, lo < 0}; pg8::gemm_phase<EpiNull, pg8::StaticOrder, false, true>(lds, g, S, E, tid); }
        { pg8::Gemm g{act, Wl + O_D2, T, D, FF}; pg8::StaticOrder S; S.init(T, D, G, cvirt);
          EpiRes<0> E{h, hb, hb, sq + 3 * T, nullptr, nullptr, 0.5f, hl8};
          pg8::gemm_phase<EpiRes<0>, pg8::StaticOrder, true, true>(lds, g, S, E, tid); }
        PHASE_END_L
        PHASE_BEGIN
        if (MK_DBL & 32) { pg8::Gemm g{hb, Wl + O_PG, T, D, D}; pg8::StaticOrder S; S.init(T, D, G, cvirt); EpiNull E{h, lo < 0}; pg8::gemm_phase<EpiNull, pg8::StaticOrder, false, true>(lds, g, S, E, tid); }
        { pg8::Gemm g{hb, Wl + O_PG, T, D, D}; pg8::StaticOrder S; S.init(T, D, G, cvirt);
          EpiRes<1> E{h, hb, hb_alt, sq + 4 * T, sq + 3 * T, ppb, 1.0f, hl8};
          pg8::gemm_phase<EpiRes<1>, pg8::StaticOrder, true, true>(lds, g, S, E, tid); }
        if (pc + 1 < hi) { if (fastbar && li + 1 < DEPTH) xcc_local_barrier(xbar, wave * 64 + lane_id_opaque()); else xcd_barrier(xbar, wave * 64 + lane_id_opaque()); } } ++pc;
    }
    PHASE_BEGIN
    {
        const u64* sq = ssq + (size_t)16 * T;
        for (int i0 = gtid; i0 < T * D / 4; i0 += 4 * NGT) {
            u32x2 q[4]; unsigned ql[4]; u64 sv[4];
#pragma unroll
            for (int k = 0; k < 4; ++k) { const int i = i0 + k * NGT; if (i < T * D / 4) { q[k] = ((const u32x2*)hb_alt)[i]; ql[k] = *(const unsigned*)(hl8 + (size_t)(i >> 8) * D + lo8_pos((i & 255) * 4)); sv[k] = sq[i >> 8]; } }
#pragma unroll
            for (int k = 0; k < 4; ++k) { const int i = i0 + k * NGT; if (i < T * D / 4) {
                const int c4 = (i & 255) * 4;
                const float r = __builtin_amdgcn_rsqf((float)sv[k] * (1.f / (1024.f * SSQ_FX)) + EPS);
                f32x4 v = {lo8_dec(bflo(q[k].x), sb(ql[k], 0)), lo8_dec(bfhi(q[k].x), sb(ql[k], 1)), lo8_dec(bflo(q[k].y), sb(ql[k], 2)), lo8_dec(bfhi(q[k].y), sb(ql[k], 3))};
                const f32x4 gg = *(const f32x4*)(norm_final + c4);
                v = v * r * gg; __builtin_nontemporal_store(v, (f32x4*)h + i); } }
        }
    }
    PHASE_END
#undef PHASE_BEGIN
#undef PHASE_END
#undef PHASE_END_L
}

constexpr int N_PHASES = 1 + 9 + 8 + 9 + 8 + 1;

extern "C" void kernel_launch(void* const* d_in, const int* in_sizes, int n_in, void* d_out, int out_size, void* d_ws, size_t ws_size, hipStream_t stream) {
    static int grid = 0;
    if (grid == 0) {
        if (n_in != 21 || out_size != T * D || ws_size < WS_END) { fprintf(stderr, "kernel_launch: unexpected shapes (n_in %d out %d ws %zu)\n", n_in, out_size, ws_size); grid = -1; return; }
        int dev = 0, cus = 0, per_cu = 0;
        hipGetDevice(&dev); hipDeviceGetAttribute(&cus, hipDeviceAttributeMultiprocessorCount, dev);
        hipFuncSetAttribute((const void*)mk_fwd, hipFuncAttributeMaxDynamicSharedMemorySize, LDS_BYTES);
        hipOccupancyMaxActiveBlocksPerMultiprocessor(&per_cu, (const void*)mk_fwd, NWAVES * 64, LDS_BYTES);
        if (per_cu < 1) { fprintf(stderr, "kernel_launch: occupancy query says %d blocks per CU\n", per_cu); per_cu = 1; }
        (void)hipGetLastError();
        grid = cus * per_cu;
    }
    if (grid < 0) return;
#if !MK_COOP
    if (hipMemsetAsync(d_ws, 0, 32768, stream) != hipSuccess) { fprintf(stderr, "kernel_launch: memset failed\n"); return; }
#endif
    Args a{};
    for (int i = 0; i < 21; ++i) a.in[i] = (const float*)d_in[i];
    a.out = (float*)d_out; a.ws = (unsigned char*)d_ws;
#if MK_COOP
    a.ph_lo = 0; a.ph_hi = N_PHASES;
    void* kargs[] = {&a};
    hipError_t e = hipLaunchCooperativeKernel((const void*)mk_fwd, dim3(grid), dim3(NWAVES * 64), kargs, LDS_BYTES, stream);
    if (e != hipSuccess) fprintf(stderr, "cooperative launch failed: %s (grid %d)\n", hipGetErrorString(e), grid);
#else
    for (int p = 0; p < N_PHASES; ++p) {
        a.ph_lo = p; a.ph_hi = p + 1;
        hipLaunchKernelGGL(mk_fwd, dim3(grid), dim3(NWAVES * 64), LDS_BYTES, stream, a);
    }
#endif
}
```

```cpp
#include <hip/hip_runtime.h>
#include <hip/hip_cooperative_groups.h>
#include <cstdio>
#include <cstdint>
namespace cg = cooperative_groups;
namespace pg8 {
#define PG8_LAS __attribute__((address_space(3)))
typedef unsigned short bf16_t;
typedef short bf16x8 __attribute__((ext_vector_type(8)));
typedef float f32x4 __attribute__((ext_vector_type(4)));
typedef unsigned u32x4 __attribute__((ext_vector_type(4)));
constexpr int BM = 256, BK = 64, HALF = 128, HTB = HALF * BK * 2  , STAGE_BYTES = 8 * HTB, NXCD = 8, WGM = 8;

__host__ __device__ __forceinline__ int lds_byte(int r, int c) { const int st = (r >> 4) * 2 + (c >> 5), rr = r & 15, cc = c & 31, ob = rr * 64 + cc * 2; return st * 1024 + (ob ^ (((ob >> 9) & 1) << 5)); }
__host__ __device__ __forceinline__ void stage_rc(int b, int& R, int& C) { const int st = b / 1024, sb = b % 1024, swz = sb ^ (((sb >> 9) & 1) << 5); R = (st >> 1) * 16 + swz / 64; C = (st & 1) * 32 + (swz % 64) / 2; }
__host__ __device__ __forceinline__ int perm32(int rho) { const int n = rho >> 4, i = rho & 15; return 8 * (i >> 2) + 4 * n + (i & 3); }

struct Unit { int pm, pn; };
struct Gemm { const bf16_t* A; const bf16_t* Bt; int M, N, K; };

struct StaticOrder {
    int nM, nN, nwg, G, c;
    __host__ __device__ void init(int M, int N, int G_, int c_) { nM = M / BM; nN = N / BM; nwg = nM * nN; G = G_; c = c_; }
    __host__ __device__ bool next(int i, Unit& u) const {
        const long L = (long)i * G + c; if (L >= nwg) return false;
        int wgid = (int)L; { const int q = nwg / NXCD, r = nwg % NXCD, xcd = wgid % NXCD, off = wgid / NXCD; wgid = (xcd < r ? xcd * (q + 1) : r * (q + 1) + (xcd - r) * q) + off; }
        const int nig = WGM * nN, gid = wgid / nig, fm = gid * WGM, gsz = (nM - fm) < WGM ? (nM - fm) : WGM;
        u.pm = fm + ((wgid % nig) % gsz); u.pn = (wgid % nig) / gsz; return true;
    }
    __device__ __forceinline__ void a_ready(const Unit&) const {}
    __device__ __forceinline__ void done(const Unit&) const {}
};


template <class Epi, class Sched, bool ALIGN_EPI = false, bool SP2 = false>
__device__ __forceinline__ void gemm_phase(PG8_LAS unsigned char* lds, const Gemm g, const Sched& S, const Epi& E, int tid_in) {
    int tid_o = tid_in; asm volatile("" : "+v"(tid_o));
    const int tid = tid_o, wid = __builtin_amdgcn_readfirstlane(tid >> 6), lane = tid & 63, wr = wid >> 2, wc = wid & 3, fr = lane & 15, fq = lane >> 4;
    const int K = g.K, nt = K / BK;
    unsigned voffA[2], voffB[2];
#pragma unroll
    for (int i = 0; i < 2; ++i) { int R, C; stage_rc(tid * 16 + i * 8192, R, C); const int Rb = Epi::PERM ? ((R & ~31) + perm32(R & 31)) : R;
        voffA[i] = (unsigned)(R * K + C) * 2u; voffB[i] = (unsigned)(Rb * K + C) * 2u; }
    const size_t kstep = (size_t)(BK * 2);
    const size_t hstep = (size_t)HALF * K * 2;
    const size_t tstep = 2 * hstep;
    const unsigned ldsw = (unsigned)wid * 1024u;
    const int aoff = lds_byte(wr * 64 + fr, fq * 8), boff = lds_byte(wc * 32 + fr, fq * 8);
#define PG8_SA(b, h) (((b) * 2 + (h)) * HTB)
#define PG8_SB(b, h) ((4 + (b) * 2 + (h)) * HTB)
#define PG8_STAGE(bufoff, gbase, voff) do { _Pragma("unroll") for (int _i = 0; _i < 2; ++_i) \
        __builtin_amdgcn_global_load_lds((const unsigned*)((const char*)(gbase) + (voff)[_i]), (PG8_LAS unsigned*)(lds + (bufoff) + ldsw + _i * 8192), 16, 0, 0); } while (0)
#define PG8_LDA(dst, b, h) do { _Pragma("unroll") for (int m = 0; m < 4; ++m) _Pragma("unroll") for (int k = 0; k < 2; ++k) dst[m][k] = *(const PG8_LAS bf16x8*)(lds + PG8_SA(b, h) + aoff + m * 2048 + k * 1024); } while (0)
#define PG8_LDB(dst, b, h) do { _Pragma("unroll") for (int n = 0; n < 2; ++n) _Pragma("unroll") for (int k = 0; k < 2; ++k) dst[n][k] = *(const PG8_LAS bf16x8*)(lds + PG8_SB(b, h) + boff + n * 2048 + k * 1024); } while (0)
#define PG8_MMA(ai, bj, At, Bt) do { __builtin_amdgcn_s_setprio(1); _Pragma("unroll") for (int m = 0; m < 4; ++m) _Pragma("unroll") for (int n = 0; n < 2; ++n) _Pragma("unroll") for (int k = 0; k < 2; ++k) \
        acc[ai][bj][m][n] = __builtin_amdgcn_mfma_f32_16x16x32_bf16(Bt[n][k], At[m][k], acc[ai][bj][m][n], 0, 0, 0); __builtin_amdgcn_s_setprio(0); } while (0)
#define PG8_WAIT_V(n) asm volatile("s_waitcnt vmcnt(" #n ")" ::: "memory")
#define PG8_WAIT_L(n) asm volatile("s_waitcnt lgkmcnt(" #n ")" ::: "memory")
#define PG8_BAR __builtin_amdgcn_s_barrier()
#define PG8_SCHED __builtin_amdgcn_sched_barrier(0)
    Unit cur, nxt; int ui = 0;
    if (!S.next(0, cur)) return;
    f32x4 acc[2][2][4][2];
#pragma unroll
    for (int a = 0; a < 2; ++a)
#pragma unroll
        for (int b = 0; b < 2; ++b)
#pragma unroll
            for (int m = 0; m < 4; ++m)
#pragma unroll
                for (int n = 0; n < 2; ++n) acc[a][b][m][n] = (f32x4){0.f, 0.f, 0.f, 0.f};
    bf16x8 At[4][2], B0[2][2], B1[2][2];
    const char* cA = (const char*)g.A + (size_t)cur.pm * tstep; const char* cB = (const char*)g.Bt + (size_t)cur.pn * tstep;
    S.a_ready(cur);
    if constexpr (SP2) {
        PG8_STAGE(PG8_SB(0, 0), cB, voffB); PG8_STAGE(PG8_SB(0, 1), cB + hstep, voffB); PG8_STAGE(PG8_SA(0, 0), cA, voffA); PG8_STAGE(PG8_SA(0, 1), cA + hstep, voffA);
        if (wr == 1) PG8_BAR;
        PG8_WAIT_V(2); PG8_BAR;
        PG8_STAGE(PG8_SB(1, 0), cB + kstep, voffB); PG8_STAGE(PG8_SA(1, 0), cA + kstep, voffA); PG8_STAGE(PG8_SB(1, 1), cB + hstep + kstep, voffB);
        PG8_WAIT_V(6); PG8_BAR;
    } else {
        PG8_STAGE(PG8_SB(0, 0), cB, voffB); PG8_STAGE(PG8_SA(0, 0), cA, voffA); PG8_STAGE(PG8_SB(0, 1), cB + hstep, voffB); PG8_STAGE(PG8_SA(0, 1), cA + hstep, voffA);
        if (wr == 1) PG8_BAR;
        PG8_WAIT_V(4); PG8_BAR;
        PG8_STAGE(PG8_SB(1, 0), cB + kstep, voffB); PG8_STAGE(PG8_SA(1, 0), cA + kstep, voffA); PG8_STAGE(PG8_SB(1, 1), cB + hstep + kstep, voffB);
        PG8_WAIT_V(6); PG8_BAR;
    }
    for (;;) {
        const bool has_next = S.next(ui + 1, nxt);
        const char* nA = has_next ? (const char*)g.A + (size_t)nxt.pm * tstep : cA; const char* nB = has_next ? (const char*)g.Bt + (size_t)nxt.pn * tstep : cB;
        for (int t = 0; t < nt; t += 2) {
            const bool last = (t == nt - 2);
            const char* a1 = cA + (size_t)(t + 1) * kstep;
            const char* a2 = last ? nA : cA + (size_t)(t + 2) * kstep; const char* b2 = last ? nB : cB + (size_t)(t + 2) * kstep;
            const char* a3 = a2 + kstep; const char* b3 = b2 + kstep;
            if (last && has_next) S.a_ready(nxt);
            if constexpr (SP2) {
            PG8_LDB(B0, 0, 0); PG8_LDB(B1, 0, 1); PG8_SCHED; PG8_LDA(At, 0, 0); PG8_STAGE(PG8_SA(1, 1), a1 + hstep, voffA);
            PG8_WAIT_V(8); PG8_WAIT_L(0); PG8_BAR; PG8_MMA(0, 0, At, B0); PG8_MMA(0, 1, At, B1); PG8_BAR; PG8_SCHED;
            PG8_LDA(At, 0, 1); PG8_STAGE(PG8_SB(0, 0), b2, voffB); PG8_STAGE(PG8_SB(0, 1), b2 + hstep, voffB); PG8_STAGE(PG8_SA(0, 0), a2, voffA);
            PG8_WAIT_V(8); PG8_WAIT_L(0); PG8_BAR; PG8_MMA(1, 0, At, B0); PG8_MMA(1, 1, At, B1); PG8_BAR; PG8_SCHED;
            PG8_LDB(B0, 1, 0); PG8_LDB(B1, 1, 1); PG8_SCHED; PG8_LDA(At, 1, 0); PG8_STAGE(PG8_SA(0, 1), a2 + hstep, voffA);
            PG8_WAIT_V(8); PG8_WAIT_L(0); PG8_BAR; PG8_MMA(0, 0, At, B0); PG8_MMA(0, 1, At, B1); PG8_BAR; PG8_SCHED;
            PG8_LDA(At, 1, 1); PG8_STAGE(PG8_SB(1, 0), b3, voffB); PG8_STAGE(PG8_SB(1, 1), b3 + hstep, voffB); PG8_STAGE(PG8_SA(1, 0), a3, voffA);
            PG8_WAIT_V(8); PG8_WAIT_L(0); PG8_BAR; PG8_MMA(1, 0, At, B0); PG8_MMA(1, 1, At, B1); PG8_BAR; PG8_SCHED;
            } else {
            PG8_LDB(B0, 0, 0); PG8_SCHED; PG8_LDA(At, 0, 0); PG8_STAGE(PG8_SA(1, 1), a1 + hstep, voffA);
            PG8_WAIT_L(8); PG8_BAR; PG8_WAIT_L(0); PG8_MMA(0, 0, At, B0); PG8_BAR; PG8_SCHED;
            PG8_LDB(B1, 0, 1); PG8_STAGE(PG8_SB(0, 0), b2, voffB);
            PG8_BAR; PG8_WAIT_L(0); PG8_MMA(0, 1, At, B1); PG8_BAR;
            PG8_LDA(At, 0, 1); PG8_STAGE(PG8_SA(0, 0), a2, voffA);
            PG8_BAR; PG8_WAIT_L(0); PG8_MMA(1, 0, At, B0); PG8_BAR; PG8_SCHED;
            PG8_STAGE(PG8_SB(0, 1), b2 + hstep, voffB);
            PG8_WAIT_V(6); PG8_BAR; PG8_MMA(1, 1, At, B1); PG8_BAR;
            PG8_LDB(B0, 1, 0); PG8_SCHED; PG8_LDA(At, 1, 0); PG8_STAGE(PG8_SA(0, 1), a2 + hstep, voffA);
            PG8_WAIT_L(8); PG8_BAR; PG8_WAIT_L(0); PG8_MMA(0, 0, At, B0); PG8_BAR; PG8_SCHED;
            PG8_LDB(B1, 1, 1); PG8_STAGE(PG8_SB(1, 0), b3, voffB);
            PG8_BAR; PG8_WAIT_L(0); PG8_MMA(0, 1, At, B1); PG8_BAR;
            PG8_LDA(At, 1, 1); PG8_STAGE(PG8_SA(1, 0), a3, voffA);
            PG8_BAR; PG8_WAIT_L(0); PG8_MMA(1, 0, At, B0); PG8_BAR; PG8_SCHED;
            PG8_STAGE(PG8_SB(1, 1), b3 + hstep, voffB);
            PG8_WAIT_V(6); PG8_BAR; PG8_MMA(1, 1, At, B1); PG8_BAR;
            }
        }
        if constexpr (ALIGN_EPI) { if (wr == 0) PG8_BAR; }
        if constexpr (!Epi::AFTER_DRAIN) { E(acc, cur, wr, wc, fr, fq); S.done(cur); }
        if (!has_next) break;
#pragma unroll
        for (int a = 0; a < 2; ++a)
#pragma unroll
            for (int b = 0; b < 2; ++b)
#pragma unroll
                for (int m = 0; m < 4; ++m)
#pragma unroll
                    for (int n = 0; n < 2; ++n) acc[a][b][m][n] = (f32x4){0.f, 0.f, 0.f, 0.f};
        cur = nxt; cA = nA; cB = nB; ++ui;
        if constexpr (ALIGN_EPI) { if (wr == 1) PG8_BAR; }
    }
    PG8_WAIT_V(0);
    if constexpr (!ALIGN_EPI) { if (wr == 0) PG8_BAR; }
    PG8_BAR;
    if constexpr (Epi::AFTER_DRAIN) { E.fused(acc, cur, wr, wc, fr, fq, lds, wid, lane); S.done(cur); }
#undef PG8_SA
#undef PG8_SB
#undef PG8_STAGE
#undef PG8_LDA
#undef PG8_LDB
#undef PG8_MMA
#undef PG8_WAIT_V
#undef PG8_WAIT_L
#undef PG8_BAR
#undef PG8_SCHED
}
}

#define LAS __attribute__((address_space(3)))
typedef unsigned short bf16_t;
typedef short bf16x8 __attribute__((ext_vector_type(8)));
typedef short s16x4 __attribute__((ext_vector_type(4)));
typedef float f32x4 __attribute__((ext_vector_type(4)));
typedef float f32x16 __attribute__((ext_vector_type(16)));
typedef unsigned u32x4 __attribute__((ext_vector_type(4)));
typedef unsigned u32x2 __attribute__((ext_vector_type(2)));

#ifndef MK_DBL
#define MK_DBL 0
#endif
#ifndef MK_BF16RES
#define MK_BF16RES 2
#endif
#ifndef MK_PF2
#define MK_PF2 0
#endif
#ifndef MK_LOCALBAR
#define MK_LOCALBAR 0
#endif
#ifndef MK_LATECONV
#define MK_LATECONV 0
#endif
#ifndef MK_NQ2
#define MK_NQ2 0
#endif
#ifndef MK_COOP
#define MK_COOP 1
#endif

constexpr int NWAVES = 8;
constexpr int T = 16384, SEQ = 8192, D = 1024, FF = 2816, NGU = 5632, NAB = 3584, NC = 3072, PLE = 256, DEPTH = 4;
constexpr int LDAB = NAB + 64, LDC = NC + 64;
__host__ __device__ constexpr size_t vt_off(int vhead, int tidx) { return ((size_t)vhead * (16384 / 64) + (size_t)(tidx >> 6)) * 4096 + (size_t)(tidx & 63); }
constexpr float EPS = 1e-6f;
constexpr float LOG2E = 1.4426950408889634f;
constexpr float SC2 = 0.125f * LOG2E;
constexpr float NEGINF = -__builtin_huge_valf();

constexpr size_t O_GU1 = 0, O_D1 = 5767168, O_GU2 = 8650752, O_D2 = 14417920, O_IN = 17301504, O_OUT = 20971520, O_PG = 22020096, O_PP = 23068672, LAYER_W = 23330816;
constexpr size_t MiB = 1u << 20;
constexpr size_t WS_SSQ = 1 * MiB, WS_COS = 3 * MiB, WS_SIN = 4 * MiB, WS_LSE = 5 * MiB, WS_W = 6 * MiB, WS_HB = 184 * MiB, WS_ACT = 216 * MiB,
                 WS_VT = 332 * MiB, WS_AO = 366 * MiB, WS_OBP = 398 * MiB, WS_PB = 422 * MiB, WS_SSQP = 454 * MiB, WS_HL8 = 458 * MiB, WS_END = 474 * MiB;
static_assert(WS_W + LAYER_W * 4 * 2 <= WS_HB && WS_ACT + (size_t)T * LDAB * 2 <= WS_VT && WS_VT + (size_t)1024 * T * 2 <= WS_AO, "ws map");
constexpr int RT_OFF = 131072 + 1024, LDS_BYTES = RT_OFF + 8192;

__device__ __forceinline__ unsigned f2bf(float f) { unsigned u = __builtin_bit_cast(unsigned, f); return (u + 0x7fffu + ((u >> 16) & 1u)) >> 16; }
__device__ __forceinline__ unsigned pk2(float lo, float hi) {
    typedef float f2_t __attribute__((ext_vector_type(2))); typedef __bf16 b2_t __attribute__((ext_vector_type(2)));
    f2_t v = {lo, hi}; b2_t b = __builtin_convertvector(v, b2_t); return __builtin_bit_cast(unsigned, b);
}
__device__ __forceinline__ float bflo(unsigned w) { return __builtin_bit_cast(float, w << 16); }
__device__ __forceinline__ float bfhi(unsigned w) { return __builtin_bit_cast(float, w & 0xffff0000u); }
__device__ __forceinline__ float wave_sum(float v) {
#pragma unroll
    for (int o = 1; o < 64; o <<= 1) v += __shfl_xor(v, o);
    return v;
}
__device__ __forceinline__ float fexp2(float x) { return __builtin_amdgcn_exp2f(x); }
__device__ __forceinline__ float frcp(float x) { return __builtin_amdgcn_rcpf(x); }
__device__ __forceinline__ float sigmoidf_(float x) { return frcp(1.f + fexp2(-x * LOG2E)); }

typedef unsigned long long u64;
constexpr float SSQ_FX = 16777216.f;
__device__ __forceinline__ float row_rstd(const u64* ssq, int row) { return __builtin_amdgcn_rsqf((float)ssq[row] * (1.f / (1024.f * SSQ_FX)) + EPS); }
__device__ __forceinline__ int lane_id_opaque() { int l; asm volatile("v_mbcnt_lo_u32_b32 %0, -1, 0\n\tv_mbcnt_hi_u32_b32 %0, -1, %0" : "=&v"(l)); return l; }
__device__ __forceinline__ float lo8_dec(float hi, int q) { const unsigned ex = __builtin_bit_cast(unsigned, hi) & 0x7f800000u; const float sc = ex >= (16u << 23) ? __builtin_bit_cast(float, ex - (15u << 23)) : 0.f; return hi + (float)q * sc; }
__device__ __forceinline__ unsigned lo8_enc(float h, float hi) {
    const unsigned ex = __builtin_bit_cast(unsigned, hi) & 0x7f800000u; const float isc = ex >= (16u << 23) ? __builtin_bit_cast(float, (269u << 23) - ex) : 0.f;
    int q = (int)__builtin_rintf((h - hi) * isc); q = q < -128 ? -128 : (q > 127 ? 127 : q); return (unsigned)q & 0xffu;
}
__device__ __forceinline__ int sb(unsigned w, int k) { return (int)(w << (24 - 8 * k)) >> 24; }
__host__ __device__ constexpr int lo8_pos(int c) { return (c & ~255) + ((c >> 5) & 3) * 64 + ((c >> 3) & 3) * 16 + ((c >> 7) & 1) * 8 + (c & 7); }
__device__ __forceinline__ void res_dec8(const u32x4 hi, const u32x2 lo, f32x4& h0, f32x4& h1) {
    h0[0] = lo8_dec(bflo(hi.x), sb(lo.x, 0)); h0[1] = lo8_dec(bfhi(hi.x), sb(lo.x, 1)); h0[2] = lo8_dec(bflo(hi.y), sb(lo.x, 2)); h0[3] = lo8_dec(bfhi(hi.y), sb(lo.x, 3));
    h1[0] = lo8_dec(bflo(hi.z), sb(lo.y, 0)); h1[1] = lo8_dec(bfhi(hi.z), sb(lo.y, 1)); h1[2] = lo8_dec(bflo(hi.w), sb(lo.y, 2)); h1[3] = lo8_dec(bfhi(hi.w), sb(lo.y, 3));
}
__device__ __forceinline__ void res_enc8(const f32x4 h0, const f32x4 h1, u32x4& hi, u32x2& lo) {
    hi.x = pk2(h0[0], h0[1]); hi.y = pk2(h0[2], h0[3]); hi.z = pk2(h1[0], h1[1]); hi.w = pk2(h1[2], h1[3]);
    lo.x = lo8_enc(h0[0], bflo(hi.x)) | (lo8_enc(h0[1], bfhi(hi.x)) << 8) | (lo8_enc(h0[2], bflo(hi.y)) << 16) | (lo8_enc(h0[3], bfhi(hi.y)) << 24);
    lo.y = lo8_enc(h1[0], bflo(hi.z)) | (lo8_enc(h1[1], bfhi(hi.z)) << 8) | (lo8_enc(h1[2], bflo(hi.w)) << 16) | (lo8_enc(h1[3], bfhi(hi.w)) << 24);
}
using pg8::Unit;

struct EpiGateUp {
    static constexpr bool PERM = true, AFTER_DRAIN = false;
    bf16_t* O; const u64* ssq; const LAS float* rt;
    __device__ __forceinline__ void operator()(const f32x4 (&acc)[2][2][4][2], const Unit& u, int wr, int wc, int fr_, int fq_) const {
        const int l_ = lane_id_opaque(), fr = l_ & 15, fq = l_ >> 4; (void)fr_; (void)fq_;
        const int row0 = u.pm * 256 + wr * 64 + fr;
        float rv[2][4];
        if (rt) {
#pragma unroll
            for (int ai = 0; ai < 2; ++ai)
#pragma unroll
                for (int m = 0; m < 4; ++m) rv[ai][m] = rt[(row0 + ai * 128 + m * 16) & 2047];
        } else {
#pragma unroll
            for (int ai = 0; ai < 2; ++ai)
#pragma unroll
                for (int m = 0; m < 4; ++m) rv[ai][m] = __builtin_amdgcn_rsqf((float)ssq[row0 + ai * 128 + m * 16] * (1.f / (1024.f * SSQ_FX)) + EPS);
        }
#pragma unroll
        for (int ai = 0; ai < 2; ++ai)
#pragma unroll
            for (int m = 0; m < 4; ++m) {
                __builtin_amdgcn_sched_barrier(0); const int row = row0 + ai * 128 + m * 16;
                const float r = rv[ai][m];
                u32x4 w;
#pragma unroll
                for (int n = 0; n < 2; ++n) {
                    const f32x4 ag = acc[ai][0][m][n], gu = ag * acc[ai][1][m][n];
                    const f32x4 ex = ag * (-r * LOG2E);
                    f32x4 den = {fexp2(ex[0]), fexp2(ex[1]), fexp2(ex[2]), fexp2(ex[3])}; den = den + 1.f;
                    const f32x4 sg = (f32x4){frcp(den[0]), frcp(den[1]), frcp(den[2]), frcp(den[3])} * (r * r);
                    const f32x4 v = gu * sg;
                    if (n == 0) { w.x = pk2(v[0], v[1]); w.y = pk2(v[2], v[3]); } else { w.z = pk2(v[0], v[1]); w.w = pk2(v[2], v[3]); }
                }
                *(u32x4*)(O + (size_t)row * FF + u.pn * 128 + wc * 32 + 8 * fq) = w;
            }
    }
};

template <int MODE> struct EpiRes {
    static constexpr bool PERM = true, AFTER_DRAIN = false; static constexpr int MB = MODE == 1 ? 1 : 2, NB = 8 / MB;
    float* h; const bf16_t* hin; bf16_t* hb; u64* ssq_out; const u64* ssq_in; const bf16_t* pp; float scale; unsigned char* hl8;
    struct Raw { u32x4 hi; u32x4 lo4; u32x4 pw; u64 sq; };
    __device__ __forceinline__ void load_batch(Raw (&w)[MB][2], int row0, int colb, int b) const {
#pragma unroll
        for (int k = 0; k < MB; ++k) {
            const int it = b * MB + k, row = row0 + (it >> 2) * 128 + (it & 3) * 16;
#pragma unroll
            for (int bj = 0; bj < 2; ++bj) {
                const size_t o = (size_t)row * D + colb + bj * 128;
                w[k][bj].hi = *(const u32x4*)(hin + o); if (bj == 0) w[k][0].lo4 = *(const u32x4*)(hl8 + (size_t)row * D + lo8_pos(colb));
                if (MODE == 1) { w[k][bj].pw = *(const u32x4*)(pp + o); if (bj == 0) w[k][0].sq = ssq_in[row]; }
            }
        }
    }
    __device__ __forceinline__ void operator()(const f32x4 (&acc)[2][2][4][2], const Unit& u, int wr, int wc, int fr_, int fq_) const {
        const int l_ = lane_id_opaque(), fr = l_ & 15, fq = l_ >> 4; (void)fr_; (void)fq_;
        const int row0 = u.pm * 256 + wr * 64 + fr, colb = u.pn * 256 + wc * 32 + 8 * fq;
        Raw w[2][MB][2];
        load_batch(w[0], row0, colb, 0);
#pragma unroll
        for (int b = 0; b < NB; ++b) {
            __builtin_amdgcn_sched_barrier(0);
            if (b + 1 < NB) load_batch(w[(b + 1) & 1], row0, colb, b + 1);
#pragma unroll
            for (int k = 0; k < MB; ++k) {
                const int it = b * MB + k, ai = it >> 2, m = it & 3, row = row0 + ai * 128 + m * 16;
                float r = 0.f;
                if (MODE == 1) r = __builtin_amdgcn_rsqf((float)w[b & 1][k][0].sq * (1.f / (1024.f * SSQ_FX)) + EPS);
                float part = 0.f; u32x4 lo_out;
#pragma unroll
                for (int bj = 0; bj < 2; ++bj) {
                    f32x4 h0, h1; { const u32x4 l4 = w[b & 1][k][0].lo4; u32x2 l2; l2.x = bj ? l4.z : l4.x; l2.y = bj ? l4.w : l4.y; res_dec8(w[b & 1][k][bj].hi, l2, h0, h1); }
                    const f32x4 a0 = acc[ai][bj][m][0], a1 = acc[ai][bj][m][1];
                    if (MODE == 0) { h0 += a0 * scale; h1 += a1 * scale; }
                    else {
                        const u32x4 q = w[b & 1][k][bj].pw;
                        h0[0] += sigmoidf_(a0[0] * r) * bflo(q.x); h0[1] += sigmoidf_(a0[1] * r) * bfhi(q.x);
                        h0[2] += sigmoidf_(a0[2] * r) * bflo(q.y); h0[3] += sigmoidf_(a0[3] * r) * bfhi(q.y);
                        h1[0] += sigmoidf_(a1[0] * r) * bflo(q.z); h1[1] += sigmoidf_(a1[1] * r) * bfhi(q.z);
                        h1[2] += sigmoidf_(a1[2] * r) * bflo(q.w); h1[3] += sigmoidf_(a1[3] * r) * bfhi(q.w);
                    }
                    u32x4 wo; u32x2 wl; res_enc8(h0, h1, wo, wl);
                    const size_t o = (size_t)row * D + colb + bj * 128;
                    *(u32x4*)(hb + o) = wo;
                    if (bj == 0) { lo_out.x = wl.x; lo_out.y = wl.y; } else { lo_out.z = wl.x; lo_out.w = wl.y; *(u32x4*)(hl8 + (size_t)row * D + lo8_pos(colb)) = lo_out; }
                    part += (h0[0] * h0[0] + h0[1] * h0[1]) + (h0[2] * h0[2] + h0[3] * h0[3]) + (h1[0] * h1[0] + h1[1] * h1[1]) + (h1[2] * h1[2] + h1[3] * h1[3]);
                }
                part += __shfl_xor(part, 16); part += __shfl_xor(part, 32);
                if (fq == 0) atomicAdd(ssq_out + row, (u64)(part * SSQ_FX));
            }
        }
    }
};

struct EpiPlain {
    static constexpr bool PERM = true, AFTER_DRAIN = false;
    bf16_t* O;
    __device__ __forceinline__ void operator()(const f32x4 (&acc)[2][2][4][2], const Unit& u, int wr, int wc, int fr_, int fq_) const {
        const int l_ = lane_id_opaque(), fr = l_ & 15, fq = l_ >> 4; (void)fr_; (void)fq_;
        const int row0 = u.pm * 256 + wr * 64 + fr;
#pragma unroll
        for (int ai = 0; ai < 2; ++ai)
#pragma unroll
            for (int m = 0; m < 4; ++m) {
                __builtin_amdgcn_sched_barrier(0); const int row = row0 + ai * 128 + m * 16;
#pragma unroll
                for (int bj = 0; bj < 2; ++bj) {
                    const int col = u.pn * 256 + bj * 128 + wc * 32 + 8 * fq;
                    const f32x4 a0 = acc[ai][bj][m][0], a1 = acc[ai][bj][m][1];
                    u32x4 w; w.x = pk2(a0[0], a0[1]); w.y = pk2(a0[2], a0[3]); w.z = pk2(a1[0], a1[1]); w.w = pk2(a1[2], a1[3]);
                    *(u32x4*)(O + (size_t)row * D + col) = w;
                }
            }
    }
};

struct EpiNull {
    static constexpr bool PERM = true, AFTER_DRAIN = false;
    float* O; int never;
    __device__ __forceinline__ void operator()(const f32x4 (&acc)[2][2][4][2], const Unit& u, int wr, int wc, int fr_, int fq_) const {
        const int l_ = lane_id_opaque(), fr = l_ & 15, fq = l_ >> 4; (void)fr_; (void)fq_;
        if (never) { f32x4 s = {0.f, 0.f, 0.f, 0.f};
#pragma unroll
            for (int ai = 0; ai < 2; ++ai)
#pragma unroll
                for (int bj = 0; bj < 2; ++bj)
#pragma unroll
                    for (int m = 0; m < 4; ++m) s += acc[ai][bj][m][0] + acc[ai][bj][m][1];
            *(f32x4*)(O + (size_t)(u.pm * 256 + wr * 64 + fr) * D + u.pn * 256 + wc * 32 + 8 * fq) = s; }
    }
};
template <int AB> struct EpiQKV {
    static constexpr bool PERM = true, AFTER_DRAIN = false;
    bf16_t* qk; bf16_t* vT; const u64* ssq; const float* ctab; const float* stab; const LAS float* rt;
    __device__ __forceinline__ void operator()(const f32x4 (&acc)[2][2][4][2], const Unit& u, int wr, int wc, int fr_, int fq_) const {
        const int l_ = lane_id_opaque(), fr = l_ & 15, fq = l_ >> 4; (void)fr_; (void)fq_;
        constexpr int LDQ = AB ? LDAB : LDC;
        const int pn = AB ? (int)((0xA98765DC32B410ULL >> (4 * u.pn)) & 15) : u.pn;
        int kind, vrow0 = 0, dsh = 0;
        if (AB) { if (pn == 4) { kind = 2; vrow0 = 0; } else if (pn >= 11) { kind = 2; vrow0 = 256 + (pn - 11) * 256; dsh = 2 * (pn - 11); } else kind = 0; }
        else { if (pn >= 8) { kind = 2; vrow0 = (pn - 8) * 256; } else kind = 1; }
        const int row0 = u.pm * 256 + wr * 64 + fr;
        float rv[2][4];
        if (rt) {
#pragma unroll
            for (int ai = 0; ai < 2; ++ai)
#pragma unroll
                for (int m = 0; m < 4; ++m) rv[ai][m] = rt[(row0 + ai * 128 + m * 16) & 2047];
        } else {
#pragma unroll
            for (int ai = 0; ai < 2; ++ai)
#pragma unroll
                for (int m = 0; m < 4; ++m) rv[ai][m] = __builtin_amdgcn_rsqf((float)ssq[row0 + ai * 128 + m * 16] * (1.f / (1024.f * SSQ_FX)) + EPS);
        }
        if (AB && kind == 0) {
            f32x4 cb[2][2], sb[2][2];
            { const int pos = row0 & (SEQ - 1); const f32x4* cp = (const f32x4*)(ctab + pos * 32 + 8 * fq); const f32x4* sp = (const f32x4*)(stab + pos * 32 + 8 * fq);
              cb[0][0] = cp[0]; cb[0][1] = cp[1]; sb[0][0] = sp[0]; sb[0][1] = sp[1]; }
#pragma unroll
            for (int it = 0; it < 8; ++it) {
                const int ai = it >> 2, m = it & 3, cur = it & 1, nx = cur ^ 1;
                __builtin_amdgcn_sched_barrier(0);
                const int row = row0 + ai * 128 + m * 16;
                if (it < 7) { const int rown = row0 + ((it + 1) >> 2) * 128 + ((it + 1) & 3) * 16, pos = rown & (SEQ - 1);
                    const f32x4* cp = (const f32x4*)(ctab + pos * 32 + 8 * fq); const f32x4* sp = (const f32x4*)(stab + pos * 32 + 8 * fq);
                    cb[nx][0] = cp[0]; cb[nx][1] = cp[1]; sb[nx][0] = sp[0]; sb[nx][1] = sp[1]; }
                const float r = rv[ai][m];
                u32x4 w1, w2;
#pragma unroll
                for (int n = 0; n < 2; ++n) {
                    const f32x4 c4 = cb[cur][n], s4 = sb[cur][n];
                    const f32x4 x1 = acc[ai][0][m][n] * r, x2 = acc[ai][1][m][n] * r;
                    const f32x4 o1 = x1 * c4 - x2 * s4, o2 = x2 * c4 + x1 * s4;
                    if (n == 0) { w1.x = pk2(o1[0], o1[1]); w1.y = pk2(o1[2], o1[3]); w2.x = pk2(o2[0], o2[1]); w2.y = pk2(o2[2], o2[3]); }
                    else { w1.z = pk2(o1[0], o1[1]); w1.w = pk2(o1[2], o1[3]); w2.z = pk2(o2[0], o2[1]); w2.w = pk2(o2[2], o2[3]); }
                }
                bf16_t* op = qk + (size_t)row * LDQ + pn * 256 + wc * 64 + 8 * fq;
                *(u32x4*)op = w1; *(u32x4*)(op + 32) = w2;
            }
            return;
        }
        if (AB && kind == 2 && dsh == 4) {
#pragma unroll
            for (int ai = 0; ai < 2; ++ai) {
                __builtin_amdgcn_sched_barrier(0);
                float rm[4];
#pragma unroll
                for (int m = 0; m < 4; ++m) rm[m] = rv[ai][m];
                const int rowb = u.pm * 256 + wr * 64 + ai * 128, s0 = rowb & (SEQ - 1), b = rowb >> 13;
                const int tidx = b * SEQ + fr * (SEQ >> 4) + (s0 >> 4);
#pragma unroll
                for (int bj = 0; bj < 2; ++bj)
#pragma unroll
                    for (int n = 0; n < 2; ++n)
#pragma unroll
                        for (int i = 0; i < 4; ++i) {
                            const int vr = vrow0 + bj * 128 + wc * 32 + 8 * fq + 4 * n + i;
                            u32x2 w; w.x = pk2(acc[ai][bj][0][n][i] * rm[0], acc[ai][bj][1][n][i] * rm[1]); w.y = pk2(acc[ai][bj][2][n][i] * rm[2], acc[ai][bj][3][n][i] * rm[3]);
                            *(u32x2*)(vT + vt_off(vr >> 6, tidx) + (size_t)(vr & 63) * 64) = w;
                        }
            }
            return;
        }
#pragma unroll
        for (int ai = 0; ai < 2; ++ai)
#pragma unroll
            for (int m = 0; m < 4; ++m) {
                __builtin_amdgcn_sched_barrier(0); const int row = row0 + ai * 128 + m * 16;
                const float r = rv[ai][m];
                if (kind == 0) {
                    const int pos = row & (SEQ - 1);
                    const f32x4* cp = (const f32x4*)(ctab + pos * 32 + 8 * fq); const f32x4* sp = (const f32x4*)(stab + pos * 32 + 8 * fq);
                    u32x4 w1, w2;
#pragma unroll
                    for (int n = 0; n < 2; ++n) {
                        const f32x4 c4 = cp[n], s4 = sp[n];
                        const f32x4 x1 = acc[ai][0][m][n] * r, x2 = acc[ai][1][m][n] * r;
                        const f32x4 o1 = x1 * c4 - x2 * s4, o2 = x2 * c4 + x1 * s4;
                        if (n == 0) { w1.x = pk2(o1[0], o1[1]); w1.y = pk2(o1[2], o1[3]); w2.x = pk2(o2[0], o2[1]); w2.y = pk2(o2[2], o2[3]); }
                        else { w1.z = pk2(o1[0], o1[1]); w1.w = pk2(o1[2], o1[3]); w2.z = pk2(o2[0], o2[1]); w2.w = pk2(o2[2], o2[3]); }
                    }
                    bf16_t* op = qk + (size_t)row * LDQ + pn * 256 + wc * 64 + 8 * fq;
                    *(u32x4*)op = w1; *(u32x4*)(op + 32) = w2;
                } else if (kind == 1) {
#pragma unroll
                    for (int bj = 0; bj < 2; ++bj) {
                        const f32x4 a0 = acc[ai][bj][m][0] * r, a1 = acc[ai][bj][m][1] * r;
                        u32x4 w; w.x = pk2(a0[0], a0[1]); w.y = pk2(a0[2], a0[3]); w.z = pk2(a1[0], a1[1]); w.w = pk2(a1[2], a1[3]);
                        *(u32x4*)(qk + (size_t)row * LDQ + pn * 256 + bj * 128 + wc * 32 + 8 * fq) = w;
                    }
                } else {
                    const int s = row & (SEQ - 1), b = row >> 13;
                    const int tidx = b * SEQ + (s & ((1 << dsh) - 1)) * (SEQ >> dsh) + (s >> dsh);
                    for (int rep = 0; rep < ((MK_DBL & 128) ? 2 : 1); ++rep)
#pragma unroll
                    for (int bj = 0; bj < 2; ++bj)
#pragma unroll
                        for (int n = 0; n < 2; ++n)
#pragma unroll
                            for (int i = 0; i < 4; ++i) {
                                const int vr = vrow0 + bj * 128 + wc * 32 + 8 * fq + 4 * n + i;
                                vT[vt_off(vr >> 6, tidx) + (size_t)(vr & 63) * 64] = (bf16_t)f2bf(acc[ai][bj][m][n][i] * r);
                            }
                }
            }
    }
};

struct PPOrder {
    int c, G, nwg;
    __device__ bool next(int i, Unit& u) const {
        if (G == 256) { if (c < 128 || i >= 2) return false; const int x = c & 7, li = ((c - 128) >> 3) * 2 + i; u.pm = 8 * x + (li >> 2); u.pn = li & 3; return true; }
        const long L = (long)i * G + c; if (L >= nwg) return false; u.pm = (int)L >> 2; u.pn = (int)L & 3; return true;
    }
    __device__ __forceinline__ void a_ready(const Unit&) const {}
    __device__ __forceinline__ void done(const Unit&) const {}
};
#define MFMA32(a, b, c) __builtin_amdgcn_mfma_f32_32x32x16_bf16((a), (b), (c), 0, 0, 0)
__device__ __forceinline__ int crow(int reg, int h) { return (reg & 3) + 8 * (reg >> 2) + 4 * h; }
struct AttnSt { f32x16 o0, o1; float m, l; };

__device__ __forceinline__ void attn_init(AttnSt& st, float m0, float l0) {
#pragma unroll
    for (int i = 0; i < 16; ++i) { st.o0[i] = 0.f; st.o1[i] = 0.f; }
    st.m = m0; st.l = l0;
}
constexpr int KROW_B = 144, VROW_B = 80, KT_BYTES = 32 * KROW_B, WAVE_LDS = 16384;
__device__ __forceinline__ int kperm(int r) { return (r & 0x13) | ((r & 4) << 1) | ((r & 8) >> 1); }
__device__ __forceinline__ int ktok(int i, int hh) { return 16 * (i >> 3) + 8 * hh + 4 * ((i >> 2) & 1) + (i & 3); }
struct KVRaw { u32x4 k[4], v[4]; };
struct KVFrag { bf16x8 kf[4], vf[2][2]; };
__device__ __forceinline__ void kv_gload(KVRaw& w, const bf16_t* kt, size_t kstride, const bf16_t* vt, int lane) {
#pragma unroll
    for (int j = 0; j < 4; ++j) w.k[j] = *(const u32x4*)(kt + (size_t)((lane >> 3) + 8 * j) * kstride + (lane & 7) * 8);
#pragma unroll
    for (int j = 0; j < 4; ++j) w.v[j] = *(const u32x4*)(vt + ((lane >> 2) + 16 * j) * 64 + (lane & 3) * 8);
}
__device__ __forceinline__ void kv_stage(const KVRaw& w, LAS unsigned char* lw, int lane) {
#pragma unroll
    for (int j = 0; j < 4; ++j) *(LAS u32x4*)(lw + ((lane >> 3) + 8 * j) * KROW_B + (lane & 7) * 16) = w.k[j];
#pragma unroll
    for (int j = 0; j < 4; ++j) *(LAS u32x4*)(lw + KT_BYTES + ((lane >> 2) + 16 * j) * VROW_B + (lane & 3) * 16) = w.v[j];
}
__device__ __forceinline__ void kv_frag(KVFrag& f, const LAS unsigned char* lw, int r, int hh) {
    const LAS unsigned char* kp = lw + kperm(r) * KROW_B + 16 * hh;
#pragma unroll
    for (int s = 0; s < 4; ++s) f.kf[s] = *(const LAS bf16x8*)(kp + 32 * s);
#pragma unroll
    for (int db = 0; db < 2; ++db)
#pragma unroll
        for (int s2 = 0; s2 < 2; ++s2) f.vf[db][s2] = *(const LAS bf16x8*)(lw + KT_BYTES + (32 * db + r) * VROW_B + 32 * s2 + 16 * hh);
}
__device__ __forceinline__ float xhalf_max(float v) { const unsigned u = __builtin_bit_cast(unsigned, v); auto r = __builtin_amdgcn_permlane32_swap(u, u, false, false); return fmaxf(__builtin_bit_cast(float, (unsigned)r[0]), __builtin_bit_cast(float, (unsigned)r[1])); }
__device__ __forceinline__ float xhalf_sum(float v) { const unsigned u = __builtin_bit_cast(unsigned, v); auto r = __builtin_amdgcn_permlane32_swap(u, u, false, false); return __builtin_bit_cast(float, (unsigned)r[0]) + __builtin_bit_cast(float, (unsigned)r[1]); }
template <bool HAS_BIAS> __device__ __forceinline__ void attn_tile(AttnSt& st, const bf16x8 (&qf)[4], const KVFrag& f, const f32x16& bias) {
    f32x16 x;
#pragma unroll
    for (int i = 0; i < 16; ++i) x[i] = 0.f;
    __builtin_amdgcn_s_setprio(1);
#pragma unroll
    for (int s = 0; s < 4; ++s) x = MFMA32(f.kf[s], qf[s], x);
    __builtin_amdgcn_s_setprio(0);
    float mx = NEGINF;
#pragma unroll
    for (int i = 0; i < 16; ++i) { x[i] = HAS_BIAS ? x[i] * SC2 + bias[i] : x[i] * SC2; mx = fmaxf(mx, x[i]); }
    mx = xhalf_max(mx);
    const float mn = fmaxf(st.m, mx);
    const float alpha = fexp2(st.m - mn);
    float ls = 0.f;
#pragma unroll
    for (int i = 0; i < 16; ++i) { x[i] = fexp2(x[i] - mn); ls += x[i]; }
    ls = xhalf_sum(ls);
    st.l = st.l * alpha + ls; st.m = mn;
#pragma unroll
    for (int i = 0; i < 16; ++i) { st.o0[i] *= alpha; st.o1[i] *= alpha; }
    u32x4 p0, p1;
    p0.x = pk2(x[0], x[1]); p0.y = pk2(x[2], x[3]); p0.z = pk2(x[4], x[5]); p0.w = pk2(x[6], x[7]);
    p1.x = pk2(x[8], x[9]); p1.y = pk2(x[10], x[11]); p1.z = pk2(x[12], x[13]); p1.w = pk2(x[14], x[15]);
    const bf16x8 pf0 = __builtin_bit_cast(bf16x8, p0), pf1 = __builtin_bit_cast(bf16x8, p1);
    __builtin_amdgcn_s_setprio(1);
    st.o0 = MFMA32(f.vf[0][0], pf0, st.o0); st.o0 = MFMA32(f.vf[0][1], pf1, st.o0);
    st.o1 = MFMA32(f.vf[1][0], pf0, st.o1); st.o1 = MFMA32(f.vf[1][1], pf1, st.o1);
    __builtin_amdgcn_s_setprio(0);
}
template <class KP, class NB, class BF> __device__ __forceinline__ void attn_loop(AttnSt& st, const bf16x8 (&qf)[4], int tlo, int thi, int lane, LAS unsigned char* lw, KP kvp, NB needb, BF biasf, bool dummy = false) {
    const int r = lane & 31, hh = lane >> 5;
    const bf16_t* kt; const bf16_t* vt; size_t ks;
#if MK_PF2
    KVRaw wa, wb;
    if (!dummy) { kvp(tlo, kt, ks, vt); kv_gload(wa, kt, ks, vt, lane);
    kvp(tlo + 1 <= thi ? tlo + 1 : thi, kt, ks, vt); kv_gload(wb, kt, ks, vt, lane); }
    for (int t = tlo; t <= thi; t += 2) {
        { if (!dummy) { kv_stage(wa, lw, lane);
          kvp(t + 2 <= thi ? t + 2 : thi, kt, ks, vt); kv_gload(wa, kt, ks, vt, lane); }
          KVFrag f; kv_frag(f, lw, r, hh);
          f32x16 bias;
          if (needb(t)) { biasf(t, bias); attn_tile<true>(st, qf, f, bias); } else attn_tile<false>(st, qf, f, bias); }
        if (t + 1 <= thi) {
          if (!dummy) { kv_stage(wb, lw, lane);
          kvp(t + 3 <= thi ? t + 3 : thi, kt, ks, vt); kv_gload(wb, kt, ks, vt, lane); }
          KVFrag f; kv_frag(f, lw, r, hh);
          f32x16 bias;
          if (needb(t + 1)) { biasf(t + 1, bias); attn_tile<true>(st, qf, f, bias); } else attn_tile<false>(st, qf, f, bias); }
    }
#else
    KVRaw wa;
    if (!dummy) { kvp(tlo, kt, ks, vt); kv_gload(wa, kt, ks, vt, lane); }
    for (int t = tlo; t <= thi; ++t) {
        if (!dummy) { kv_stage(wa, lw, lane);
          kvp(t + 1 <= thi ? t + 1 : thi, kt, ks, vt); kv_gload(wa, kt, ks, vt, lane); }
        KVFrag f; kv_frag(f, lw, r, hh);
        f32x16 bias;
        if (needb(t)) { biasf(t, bias); attn_tile<true>(st, qf, f, bias); } else attn_tile<false>(st, qf, f, bias);
    }
#endif
}
__device__ __forceinline__ void attn_store(const AttnSt& st, bf16_t* orow, int hh) {
    const float inv = 1.f / st.l;
#pragma unroll
    for (int g = 0; g < 4; g += 2) {
#pragma unroll
        for (int hb = 0; hb < 2; ++hb) {
            const f32x16& o = hb ? st.o1 : st.o0;
            unsigned ax = pk2(o[4 * g] * inv, o[4 * g + 1] * inv), ay = pk2(o[4 * g + 2] * inv, o[4 * g + 3] * inv);
            unsigned bx = pk2(o[4 * g + 4] * inv, o[4 * g + 5] * inv), by = pk2(o[4 * g + 6] * inv, o[4 * g + 7] * inv);
            { auto rx = __builtin_amdgcn_permlane32_swap(ax, bx, false, false); ax = rx[0]; bx = rx[1]; }
            { auto ry = __builtin_amdgcn_permlane32_swap(ay, by, false, false); ay = ry[0]; by = ry[1]; }
            u32x4 w; w.x = ax; w.y = ay; w.z = bx; w.w = by;
            *(u32x4*)(orow + 32 * hb + 8 * (g + hh)) = w;
        }
    }
}
__device__ __forceinline__ void load_q(bf16x8 (&qf)[4], const bf16_t* qrow, int hh) {
#pragma unroll
    for (int s = 0; s < 4; ++s) qf[s] = *(const bf16x8*)(qrow + 16 * s + 8 * hh);
}

__device__ __forceinline__ void attn_a_unit(int unit, const bf16_t* qk, const bf16_t* vT, const float* sink, bf16_t* ao, LAS unsigned char* lw, int lane, bool dummy = false, bool never = false) {
    const int r = lane & 31, hh = lane >> 5;
    const int qt = (unit / 3) & 255, kvh = (unit / 768) & 3, b = unit / 3072, h = kvh * 3 + unit % 3;
    const int q0 = 32 * qt, qrow = b * SEQ + q0 + r;
    bf16x8 qf[4]; load_q(qf, qk + (size_t)qrow * LDAB + h * 64, hh);
    AttnSt st; attn_init(st, sink[h] * LOG2E, 1.f);
    const int tlo = qt - 4 < 0 ? 0 : qt - 4, thi = qt + 4 > 255 ? 255 : qt + 4;
    const bf16_t* kbase = qk + (size_t)(b * SEQ) * LDAB + 768 + kvh * 64;
    attn_loop(st, qf, tlo, thi, lane, lw,
        [&](int t, const bf16_t*& kt, size_t& ks, const bf16_t*& vt) { kt = kbase + (size_t)(32 * t) * LDAB; ks = LDAB; vt = vT + vt_off(kvh, b * SEQ + 32 * t); },
        [&](int t) { return t - qt > 3 || qt - t > 3; },
        [&](int t, f32x16& bias) {
#pragma unroll
            for (int i = 0; i < 16; ++i) { const int dk = (32 * t + ktok(i, hh)) - (q0 + r); bias[i] = (dk <= 128 && dk >= -128) ? 0.f : NEGINF; } }, dummy);
    if (!dummy || never) attn_store(st, ao + (size_t)qrow * D + h * 64, hh);
}
__device__ __forceinline__ void attn_b_unit(int unit, const bf16_t* qk, const bf16_t* vT, bf16_t* obp, float* lse, LAS unsigned char* lw, int lane, bool dummy = false, bool never = false) {
    const int r = lane & 31, hh = lane >> 5;
    const int gi = unit >> 11, idx = unit & 2047, dsh = 2 * gi, d = 1 << dsh, ntile = 256 >> dsh, sub = SEQ >> dsh;
    const int ut = idx % ntile, rr = (idx / ntile) % d, sl = (idx >> 8) & 3, b = idx >> 10, hb = gi * 4 + sl;
    const int u0 = 32 * ut, qrow = b * SEQ + (u0 + r) * d + rr;
    bf16x8 qf[4]; load_q(qf, qk + (size_t)qrow * LDAB + 1280 + hb * 64, hh);
    AttnSt st; attn_init(st, -1e30f, 0.f);
    const int tlo = ut - 2 < 0 ? 0 : ut - 2, thi = ut + 2 > ntile - 1 ? ntile - 1 : ut + 2;
    const bf16_t* kbase = qk + (size_t)(b * SEQ + rr) * LDAB + 2048 + hb * 64;
    const size_t kstr = (size_t)d * LDAB;
    attn_loop(st, qf, tlo, thi, lane, lw,
        [&](int t, const bf16_t*& kt, size_t& ks, const bf16_t*& vt) { kt = kbase + (size_t)(32 * t) * kstr; ks = kstr; vt = vT + vt_off(4 + hb, b * SEQ + rr * sub + 32 * t); },
        [&](int t) { return t - ut > 1 || ut - t > 1; },
        [&](int t, f32x16& bias) {
#pragma unroll
            for (int i = 0; i < 16; ++i) { const int dk = (32 * t + ktok(i, hh)) - (u0 + r); bias[i] = (dk <= 64 && dk >= -64) ? 0.f : NEGINF; } }, dummy);
    if (!dummy || never) attn_store(st, obp + ((size_t)gi * T + qrow) * 256 + sl * 64, hh);
    if (hh == 0 && (!dummy || never)) lse[((size_t)gi * T + qrow) * 4 + sl] = st.m + __builtin_amdgcn_logf(st.l);
}
__device__ __forceinline__ void attn_c_unit(int unit, int& cur_h, const bf16_t* qk, const bf16_t* vT, const float* rpb, bf16_t* ao, LAS unsigned char* lw, int lane, bool dummy = false, bool never = false) {
    LAS float* rp = (LAS float*)(lw + 12288);
    const int r = lane & 31, hh = lane >> 5;
    const int cg = unit & 3, rpair = (unit >> 2) & 63, b = (unit >> 8) & 1, h = unit >> 9;
    if (h != cur_h) { for (int x = lane; x < 465; x += 64) rp[x] = rpb[h * 465 + x] * LOG2E; cur_h = h; }
    const int gi = 2 * rpair + (r >> 4), j = 16 * cg + (r & 15), qrow = b * SEQ + gi * 64 + j;
    int rsq = gi - 4; rsq = rsq < 0 ? 0 : (rsq > 120 ? 120 : rsq);
    int cs = j - 8; cs = cs < 0 ? 0 : (cs > 48 ? 48 : cs);
    int rs0 = 2 * rpair - 4; rs0 = rs0 < 0 ? 0 : (rs0 > 120 ? 120 : rs0);
    int rs1 = 2 * rpair - 3; rs1 = rs1 < 0 ? 0 : (rs1 > 120 ? 120 : rs1);
    const int c0 = cg == 0 ? 0 : (cg == 1 ? 8 : (cg == 2 ? 24 : 32));
    bf16x8 qf[4]; load_q(qf, qk + (size_t)qrow * LDC + h * 64, hh);
    AttnSt st; attn_init(st, -1e30f, 0.f);
    const bf16_t* kbase = qk + (size_t)(b * SEQ + rs0 * 64 + c0) * LDC + 1024 + h * 64;
    attn_loop(st, qf, 0, rs1 - rs0 + 7, lane, lw,
        [&](int t, const bf16_t*& kt, size_t& ks, const bf16_t*& vt) { kt = kbase + (size_t)(64 * t) * LDC; ks = LDC; vt = vT + vt_off(h, b * SEQ + (rs0 + t) * 64 + c0); },
        [&](int) { return true; },
        [&](int t, f32x16& bias) {
            const int kr = rs0 + t; const bool rowok = (kr >= rsq) && (kr < rsq + 8);
            const int rbase = rowok ? (kr - gi + 7) * 31 + (c0 - j + 15) : 0, cb = c0 - cs;
#pragma unroll
            for (int i = 0; i < 16; ++i) { const int kk = ktok(i, hh); const bool ok = rowok && ((unsigned)(cb + kk) < 16u); bias[i] = ok ? rp[ok ? rbase + kk : 0] : NEGINF; } }, dummy);
    if (!dummy || never) attn_store(st, ao + (size_t)qrow * D + h * 64, hh);
}


template <bool HAS_BIAS, class BI> __device__ __forceinline__ void attn_tile2(AttnSt& st, const bf16x8 (&qf)[4], const LAS unsigned char* lw, int r, int hh, BI bias_i) {
    f32x16 x;
#pragma unroll
    for (int i = 0; i < 16; ++i) x[i] = 0.f;
    { const LAS unsigned char* kp = lw + kperm(r) * KROW_B + 16 * hh;
#pragma unroll
      for (int s = 0; s < 4; ++s) x = MFMA32(*(const LAS bf16x8*)(kp + 32 * s), qf[s], x); }
    float mx = NEGINF;
#pragma unroll
    for (int i = 0; i < 16; ++i) { x[i] = HAS_BIAS ? x[i] * SC2 + bias_i(i) : x[i] * SC2; mx = fmaxf(mx, x[i]); }
    mx = xhalf_max(mx);
    const float mn = fmaxf(st.m, mx);
    const float alpha = fexp2(st.m - mn);
    float ls = 0.f;
#pragma unroll
    for (int i = 0; i < 16; ++i) { x[i] = fexp2(x[i] - mn); ls += x[i]; }
    ls = xhalf_sum(ls);
    st.l = st.l * alpha + ls; st.m = mn;
#pragma unroll
    for (int i = 0; i < 16; ++i) { st.o0[i] *= alpha; st.o1[i] *= alpha; }
    u32x4 p0, p1;
    p0.x = pk2(x[0], x[1]); p0.y = pk2(x[2], x[3]); p0.z = pk2(x[4], x[5]); p0.w = pk2(x[6], x[7]);
    p1.x = pk2(x[8], x[9]); p1.y = pk2(x[10], x[11]); p1.z = pk2(x[12], x[13]); p1.w = pk2(x[14], x[15]);
    const bf16x8 pf0 = __builtin_bit_cast(bf16x8, p0), pf1 = __builtin_bit_cast(bf16x8, p1);
    const LAS unsigned char* vp = lw + KT_BYTES + r * VROW_B + 16 * hh;
    st.o0 = MFMA32(*(const LAS bf16x8*)(vp), pf0, st.o0); st.o0 = MFMA32(*(const LAS bf16x8*)(vp + 32), pf1, st.o0);
    st.o1 = MFMA32(*(const LAS bf16x8*)(vp + 32 * VROW_B), pf0, st.o1); st.o1 = MFMA32(*(const LAS bf16x8*)(vp + 32 * VROW_B + 32), pf1, st.o1);
}
template <class KP, class NB, class BF> __device__ __forceinline__ void attn_loop2(AttnSt& s0, AttnSt& s1, const bf16x8 (&q0)[4], const bf16x8 (&q1)[4], int lo0, int hi0, int lo1, int hi1,
                                                                                  int lane, LAS unsigned char* lw, KP kvp, NB needb, BF biasf) {
    const int r = lane & 31, hh = lane >> 5;
    const int tlo = lo0 < lo1 ? lo0 : lo1, thi = hi0 > hi1 ? hi0 : hi1;
    const bf16_t* kt; const bf16_t* vt; size_t ks;
    KVRaw wa;
    kvp(tlo, kt, ks, vt); kv_gload(wa, kt, ks, vt, lane);
    for (int t = tlo; t <= thi; ++t) {
        { const int ln = lane_id_opaque();
          kv_stage(wa, lw, ln);
          kvp(t + 1 <= thi ? t + 1 : thi, kt, ks, vt); kv_gload(wa, kt, ks, vt, ln); }
        if (t >= lo0 && t <= hi0) { auto bi = biasf(0, t); if (needb(0, t)) attn_tile2<true>(s0, q0, lw, r, hh, bi); else attn_tile2<false>(s0, q0, lw, r, hh, bi); }
        if (t >= lo1 && t <= hi1) { auto bi = biasf(1, t); if (needb(1, t)) attn_tile2<true>(s1, q1, lw, r, hh, bi); else attn_tile2<false>(s1, q1, lw, r, hh, bi); }
    }
}
__device__ __forceinline__ void attn_a2_unit(int unit, const bf16_t* qk, const bf16_t* vT, const float* sink, bf16_t* ao, LAS unsigned char* lw, int lane) {
    const int r = lane & 31, hh = lane >> 5;
    const int qtp = unit & 127, h = (unit >> 7) % 12, b = unit / (128 * 12), kvh = h / 3;
    const int qa = 2 * qtp, q0 = 32 * qa, qrow = b * SEQ + q0 + r;
    bf16x8 qf0[4], qf1[4]; load_q(qf0, qk + (size_t)qrow * LDAB + h * 64, hh); load_q(qf1, qk + (size_t)(qrow + 32) * LDAB + h * 64, hh);
    AttnSt s0, s1; attn_init(s0, sink[h] * LOG2E, 1.f); attn_init(s1, sink[h] * LOG2E, 1.f);
    const int lo0 = qa - 4 < 0 ? 0 : qa - 4, hi0 = qa + 4 > 255 ? 255 : qa + 4, lo1 = qa - 3 < 0 ? 0 : qa - 3, hi1 = qa + 5 > 255 ? 255 : qa + 5;
    const bf16_t* kbase = qk + (size_t)(b * SEQ) * LDAB + 768 + kvh * 64;
    attn_loop2(s0, s1, qf0, qf1, lo0, hi0, lo1, hi1, lane, lw,
        [&](int t, const bf16_t*& kt, size_t& ks, const bf16_t*& vt) { kt = kbase + (size_t)(32 * t) * LDAB; ks = LDAB; vt = vT + vt_off(kvh, b * SEQ + 32 * t); },
        [&](int w, int t) { const int dq = t - (qa + w); return dq > 3 || dq < -3; },
        [&](int w, int t) { int base = 32 * t - (q0 + 32 * w + r) + 8 * hh; asm volatile("" : "+v"(base));
            return [base](int i) { const int dk = base + (16 * (i >> 3) + 4 * ((i >> 2) & 1) + (i & 3)); return (dk <= 128 && dk >= -128) ? 0.f : NEGINF; }; });
    attn_store(s0, ao + (size_t)qrow * D + h * 64, hh); attn_store(s1, ao + (size_t)(qrow + 32) * D + h * 64, hh);
}
__device__ __forceinline__ void attn_b2_unit(int unit, const bf16_t* qk, const bf16_t* vT, bf16_t* obp, float* lse, LAS unsigned char* lw, int lane) {
    const int r = lane & 31, hh = lane >> 5;
    const int gi = unit >> 10, idx = unit & 1023, dsh = 2 * gi, d = 1 << dsh, ntile = 256 >> dsh, ntile2 = 128 >> dsh, sub = SEQ >> dsh;
    const int utp = (idx & 127) % ntile2, rr = (idx & 127) / ntile2, sl = (idx >> 7) & 3, b = idx >> 9, hb = gi * 4 + sl;
    const int ua = 2 * utp, u0 = 32 * ua, qrow0 = b * SEQ + (u0 + r) * d + rr, qrow1 = qrow0 + 32 * d;
    bf16x8 qf0[4], qf1[4]; load_q(qf0, qk + (size_t)qrow0 * LDAB + 1280 + hb * 64, hh); load_q(qf1, qk + (size_t)qrow1 * LDAB + 1280 + hb * 64, hh);
    AttnSt s0, s1; attn_init(s0, -1e30f, 0.f); attn_init(s1, -1e30f, 0.f);
    const int lo0 = ua - 2 < 0 ? 0 : ua - 2, hi0 = ua + 2 > ntile - 1 ? ntile - 1 : ua + 2, lo1 = ua - 1 < 0 ? 0 : ua - 1, hi1 = ua + 3 > ntile - 1 ? ntile - 1 : ua + 3;
    const bf16_t* kbase = qk + (size_t)(b * SEQ + rr) * LDAB + 2048 + hb * 64;
    const size_t kstr = (size_t)d * LDAB;
    attn_loop2(s0, s1, qf0, qf1, lo0, hi0, lo1, hi1, lane, lw,
        [&](int t, const bf16_t*& kt, size_t& ks, const bf16_t*& vt) { kt = kbase + (size_t)(32 * t) * kstr; ks = kstr; vt = vT + vt_off(4 + hb, b * SEQ + rr * sub + 32 * t); },
        [&](int w, int t) { const int dq = t - (ua + w); return dq > 1 || dq < -1; },
        [&](int w, int t) { int base = 32 * t - (u0 + 32 * w + r) + 8 * hh; asm volatile("" : "+v"(base));
            return [base](int i) { const int dk = base + (16 * (i >> 3) + 4 * ((i >> 2) & 1) + (i & 3)); return (dk <= 64 && dk >= -64) ? 0.f : NEGINF; }; });
    attn_store(s0, obp + ((size_t)gi * T + qrow0) * 256 + sl * 64, hh); attn_store(s1, obp + ((size_t)gi * T + qrow1) * 256 + sl * 64, hh);
    if (hh == 0) { lse[((size_t)gi * T + qrow0) * 4 + sl] = s0.m + __builtin_amdgcn_logf(s0.l); lse[((size_t)gi * T + qrow1) * 4 + sl] = s1.m + __builtin_amdgcn_logf(s1.l); }
}
__device__ __forceinline__ void attn_c2_unit(int unit, int& cur_h, const bf16_t* qk, const bf16_t* vT, const float* rpb, bf16_t* ao, LAS unsigned char* lw, int lane) {
    LAS float* rp = (LAS float*)(lw + 12288);
    const int r = lane & 31, hh = lane >> 5;
    const int cg = unit & 3, P = (unit >> 2) & 31, b = (unit >> 7) & 1, h = unit >> 8;
    if (h != cur_h) { for (int x = lane; x < 465; x += 64) rp[x] = rpb[h * 465 + x] * LOG2E; cur_h = h; }
    const int j = 16 * cg + (r & 15), gi0 = 4 * P + (r >> 4), qrow0 = b * SEQ + gi0 * 64 + j, qrow1 = qrow0 + 128;
    auto clampr = [](int x) { return x < 0 ? 0 : (x > 120 ? 120 : x); };
    const int rs0 = clampr(4 * P - 4);
    const int lo0 = 0, hi0 = clampr(4 * P - 3) + 7 - rs0, lo1 = clampr(4 * P - 2) - rs0, hi1 = clampr(4 * P - 1) + 7 - rs0;
    const int c0 = cg == 0 ? 0 : (cg == 1 ? 8 : (cg == 2 ? 24 : 32));
    bf16x8 qf0[4], qf1[4]; load_q(qf0, qk + (size_t)qrow0 * LDC + h * 64, hh); load_q(qf1, qk + (size_t)qrow1 * LDC + h * 64, hh);
    AttnSt s0, s1; attn_init(s0, -1e30f, 0.f); attn_init(s1, -1e30f, 0.f);
    const bf16_t* kbase = qk + (size_t)(b * SEQ + rs0 * 64 + c0) * LDC + 1024 + h * 64;
    attn_loop2(s0, s1, qf0, qf1, lo0, hi0, lo1, hi1, lane, lw,
        [&](int t, const bf16_t*& kt, size_t& ks, const bf16_t*& vt) { kt = kbase + (size_t)(64 * t) * LDC; ks = LDC; vt = vT + vt_off(h, b * SEQ + (rs0 + t) * 64 + c0); },
        [&](int, int) { return true; },
        [&](int w, int t) {
            const int kr = rs0 + t, gq = gi0 + 2 * w, rsq = clampr(gq - 4); const bool rowok = (kr >= rsq) && (kr < rsq + 8);
            int cs = j - 8; cs = cs < 0 ? 0 : (cs > 48 ? 48 : cs);
            int rb = (rowok ? (kr - gq + 7) * 31 + (c0 - j + 15) : 0) + 8 * hh, cbb = (rowok ? c0 - cs : 1000) + 8 * hh; asm volatile("" : "+v"(rb), "+v"(cbb));
            return [rb, cbb, rp](int i) { const int kk0 = 16 * (i >> 3) + 4 * ((i >> 2) & 1) + (i & 3); const bool ok = (unsigned)(cbb + kk0) < 16u; return ok ? rp[ok ? rb + kk0 : 0] : NEGINF; }; });
    { const int l2 = lane_id_opaque(), r2 = l2 & 31, hh2 = l2 >> 5;
      const size_t q0r = (size_t)(b * SEQ + (4 * P + (r2 >> 4)) * 64 + 16 * cg + (r2 & 15));
      attn_store(s0, ao + q0r * D + h * 64, hh2); attn_store(s1, ao + (q0r + 128) * D + h * 64, hh2); }
}

__device__ __forceinline__ int dest_row(int mode, int n) {
    if (mode == 1) return 256 * (n >> 7) + (n & 127);
    if (mode == 2) return 256 * (n >> 7) + 128 + (n & 127);
    if (mode == 3) {
        const int base = (int)((0x763DCBA9825410ULL >> (4 * (n >> 8))) & 15) * 256;
        if (n < 1024 || (n >= 1280 && n < 2816)) { const int d = n & 63; return base + (d >> 5) * 128 + ((n >> 6) & 3) * 32 + (d & 31); }
        return base + (n & 255);
    }
    return n;
}
__device__ __forceinline__ void tr_item(const float* W, int K, int N, const float* gain, bf16_t* WT, int mode, LAS float* scr, int item, int lane) {
    const int nblk = N / 32, kb = item / nblk, nb = item % nblk, k0 = 64 * kb, n0 = 32 * nb;
    float wv[32];
#pragma unroll
    for (int i = 0; i < 32; ++i) wv[i] = __builtin_nontemporal_load(W + (size_t)(k0 + 2 * i + (lane >> 5)) * N + n0 + (lane & 31));
#pragma unroll
    for (int i = 0; i < 32; ++i) scr[(2 * i + (lane >> 5)) * 33 + (lane & 31)] = wv[i];
    asm volatile("s_waitcnt lgkmcnt(0)" ::: "memory");
    const int c = lane & 7;
    f32x4 g0 = {1.f, 1.f, 1.f, 1.f}, g1 = g0;
    if (gain) { g0 = *(const f32x4*)(gain + k0 + 8 * c); g1 = *(const f32x4*)(gain + k0 + 8 * c + 4); }
#pragma unroll
    for (int jj = 0; jj < 4; ++jj) {
        const int n = (lane >> 3) + 8 * jj; const LAS float* s = scr + (8 * c) * 33 + n;
        u32x4 o; o.x = pk2(s[0 * 33] * g0[0], s[1 * 33] * g0[1]); o.y = pk2(s[2 * 33] * g0[2], s[3 * 33] * g0[3]);
        o.z = pk2(s[4 * 33] * g1[0], s[5 * 33] * g1[1]); o.w = pk2(s[6 * 33] * g1[2], s[7 * 33] * g1[3]);
        *(u32x4*)(WT + (size_t)dest_row(mode, n0 + n) * K + k0 + 8 * c) = o;
    }
    asm volatile("s_waitcnt lgkmcnt(0)" ::: "memory");
}

#define XB_TMO      128
#define XB_XCNT(j)  (256  + 64 * (j))
#define XB_XSUB(j)  (1280 + 64 * (j))
#define XB_XGEN(j)  (2304 + 64 * (j))
#define XB_TOP      3328
#define XB_TOPGEN   3392
#define XCD_BAR_WORDS 3456
#define XB_SPIN_CAP (1u << 18)

__device__ __forceinline__ unsigned xb_ld(unsigned* p)              { return __hip_atomic_load(p, __ATOMIC_RELAXED, __HIP_MEMORY_SCOPE_AGENT); }
__device__ __forceinline__ unsigned xb_add(unsigned* p, unsigned v) { return __hip_atomic_fetch_add(p, v, __ATOMIC_RELAXED, __HIP_MEMORY_SCOPE_AGENT); }
__device__ __forceinline__ unsigned xb_xcc_id() { return (unsigned)__builtin_amdgcn_s_getreg((3 << 11) | 20) & 0xFu; }
#define XB_SPIN(cond, bar) do { unsigned _sp = 0; while (cond) { __builtin_amdgcn_s_sleep(1); \
    if ((++_sp & 255u) == 0u) { if (xb_ld(&(bar)[XB_TMO])) break; if (_sp > XB_SPIN_CAP) { atomicAdd(&(bar)[XB_TMO], 1u); break; } } } } while (0)

struct XcdBarrier {
    unsigned* bar; unsigned x;
    volatile LAS unsigned* st;
};

__device__ __forceinline__ XcdBarrier xcd_barrier_post(unsigned* bar, volatile LAS unsigned* st) {
    XcdBarrier b; b.bar = bar; b.x = xb_xcc_id(); b.st = st;
    if (threadIdx.x == 0) st[8] = xb_add(&bar[XB_XCNT(b.x)], 1u);
    return b;
}
__device__ __forceinline__ void xcd_barrier_complete(unsigned* bar, unsigned x, unsigned& nloc, unsigned& nx) {
    const unsigned G = gridDim.x * gridDim.y * gridDim.z;
    unsigned sum, cnt, mine, sp = 0u;
    for (;;) {
        sum = 0u; cnt = 0u; mine = 0u;
#pragma unroll
        for (unsigned j = 0; j < 16; ++j) { const unsigned c = xb_ld(&bar[XB_XCNT(j)]); sum += c; cnt += (c > 0u) ? 1u : 0u; mine = (j == x) ? c : mine; }
        if (sum == G) break;
        __builtin_amdgcn_s_sleep(1);
        if ((++sp & 255u) == 0u) { if (xb_ld(&bar[XB_TMO])) break; if (sp > XB_SPIN_CAP) { atomicAdd(&bar[XB_TMO], 1u); break; } }
    }
    nloc = mine > 0u ? mine : 1u; nx = cnt > 0u ? cnt : 1u;
}

__device__ __forceinline__ void xcd_barrier(const XcdBarrier& b, int tid) {
    asm volatile("s_waitcnt vmcnt(0)" ::: "memory");
    __syncthreads();
    if (tid == 0) {
        unsigned* bar = b.bar;
        __builtin_amdgcn_s_waitcnt(0);
        unsigned nloc = b.st[0], nx = b.st[1];
        if (nloc == 0u) { xcd_barrier_complete(bar, b.x, nloc, nx); b.st[0] = nloc; b.st[1] = nx; }
        const unsigned old = xb_add(&bar[XB_XSUB(b.x)], 1u);
        const unsigned gen = old / nloc;
        if (old + 1u == (gen + 1u) * nloc) {
            __builtin_amdgcn_fence(__ATOMIC_RELEASE, "agent");
            asm volatile("s_waitcnt vmcnt(0)" ::: "memory");
            const unsigned og = xb_add(&bar[XB_TOP], 1u);
            const unsigned tg = og / nx;
            if (og + 1u == (tg + 1u) * nx) xb_add(&bar[XB_TOPGEN], 1u);
            else XB_SPIN(xb_ld(&bar[XB_TOPGEN]) == tg, bar);
            __builtin_amdgcn_fence(__ATOMIC_ACQUIRE, "agent");
            xb_add(&bar[XB_XGEN(b.x)], 1u);
            asm volatile("s_waitcnt vmcnt(0)" ::: "memory");
        } else {
            XB_SPIN(xb_ld(&bar[XB_XGEN(b.x)]) == gen, bar);
            __builtin_amdgcn_fence(__ATOMIC_ACQUIRE, "agent");
            asm volatile("s_waitcnt vmcnt(0)" ::: "memory");
        }
    }
    __syncthreads();
}


#define LB_SUB(j) (4096 + 64 * (j))
#define LB_GEN(j) (5120 + 64 * (j))
#define LB_BAD 6400
__device__ __forceinline__ void xcc_local_barrier(const XcdBarrier& b, int tid) {
    asm volatile("s_waitcnt vmcnt(0)" ::: "memory");
    __syncthreads();
    if (tid == 0) {
        unsigned* bar = b.bar; const unsigned nloc = b.st[0];
        const unsigned old = xb_add(&bar[LB_SUB(b.x)], 1u), gen = old / nloc;
        if (old + 1u == (gen + 1u) * nloc) xb_add(&bar[LB_GEN(b.x)], 1u);
        else XB_SPIN(xb_ld(&bar[LB_GEN(b.x)]) == gen, bar);
        __builtin_amdgcn_fence(__ATOMIC_ACQUIRE, "agent");
        asm volatile("s_waitcnt vmcnt(0)" ::: "memory");
    }
    __syncthreads();
}
struct Args {
    const float* in[21]; float* out; unsigned char* ws; int ph_lo, ph_hi;
};

__global__ void __launch_bounds__(NWAVES * 64, 2) mk_fwd(Args args) {
    extern __shared__ __attribute__((aligned(16))) unsigned char lds_raw[];
    LAS unsigned char* lds = (LAS unsigned char*)lds_raw;
    cg::grid_group grid = cg::this_grid();
    const int wave = __builtin_amdgcn_readfirstlane((int)threadIdx.x >> 6);
    const int G = gridDim.x, gw = blockIdx.x * NWAVES + wave, NGW = G * NWAVES, NGT = G * NWAVES * 64;
    unsigned char* ws = args.ws;
    if (threadIdx.x < 16) ((LAS unsigned*)(lds + 131072))[threadIdx.x] = 0u;
    __syncthreads();
    if (args.ph_hi - args.ph_lo > 1) {
        if (blockIdx.x == 0) { for (int w = threadIdx.x; w < 8192; w += NWAVES * 64) ((unsigned*)ws)[w] = 0u; __threadfence(); }
        grid.sync();
    }
    const XcdBarrier xbar = xcd_barrier_post((unsigned*)ws, (volatile LAS unsigned*)(lds + 131072));
    bool fastmap = false; int cvirt = (int)blockIdx.x; int gwa = gw;
    const float* x = args.in[0]; const float* p_in = args.in[1];
    const float* norm_ffn1 = args.in[2]; const float* f1g = args.in[3]; const float* f1u = args.in[4]; const float* f1d = args.in[5];
    const float* norm_mix = args.in[6]; const float* w_in_ab = args.in[7]; const float* sink_a = args.in[8]; const float* w_out_ab = args.in[9];
    const float* w_in_c = args.in[10]; const float* rpb_c = args.in[11]; const float* w_out_c = args.in[12];
    const float* norm_ffn2 = args.in[13]; const float* f2g = args.in[14]; const float* f2u = args.in[15]; const float* f2d = args.in[16];
    const float* norm_ple = args.in[17]; const float* w_pg = args.in[18]; const float* w_pp = args.in[19]; const float* norm_final = args.in[20];
    float* h = args.out;
    u64* ssq = (u64*)(ws + WS_SSQP); float* ctab = (float*)(ws + WS_COS); float* stab = (float*)(ws + WS_SIN); float* lse = (float*)(ws + WS_LSE);
    bf16_t* Wb = (bf16_t*)(ws + WS_W); bf16_t* hb = (bf16_t*)(ws + WS_HB); bf16_t* act = (bf16_t*)(ws + WS_ACT); bf16_t* qk = act;
    bf16_t* vT = (bf16_t*)(ws + WS_VT); bf16_t* hb_alt = vT; bf16_t* ao = (bf16_t*)(ws + WS_AO); bf16_t* ppb = ao; bf16_t* obp = (bf16_t*)(ws + WS_OBP); bf16_t* pb = (bf16_t*)(ws + WS_PB); unsigned char* hl8 = ws + WS_HL8;
    const int lo = args.ph_lo, hi = args.ph_hi;
    const bool fastbar = MK_LOCALBAR && fastmap;
    constexpr int I_GU = 16 * 88, I_DN = 44 * 32, I_IN = 16 * 112, I_INC = 16 * 96, I_SQ = 16 * 32, I_PP = 4 * 32;
    constexpr int L_ITEMS = 6 * I_GU   + I_IN + 2 * I_SQ + I_PP;
    static_assert(I_GU == I_DN, "items");
    auto convert_items = [&](int first, int step, int it_end, int lane) {
        LAS float* scr = (LAS float*)(lds + wave * 16384);
        for (int it = first; it < it_end; it += step) {
            const int li = it / L_ITEMS; int r = it % L_ITEMS; const int j = li >> 1;
            bf16_t* Wl = Wb + (size_t)li * LAYER_W;
            const size_t fo = (size_t)li * D * FF;
            if (r < I_GU) { tr_item(f1g + fo, D, FF, norm_ffn1 + li * D, Wl + O_GU1, 1, scr, r, lane); continue; } r -= I_GU;
            if (r < I_GU) { tr_item(f1u + fo, D, FF, norm_ffn1 + li * D, Wl + O_GU1, 2, scr, r, lane); continue; } r -= I_GU;
            if (r < I_DN) { tr_item(f1d + fo, FF, D, nullptr, Wl + O_D1, 0, scr, r, lane); continue; } r -= I_DN;
            if (r < I_GU) { tr_item(f2g + fo, D, FF, norm_ffn2 + li * D, Wl + O_GU2, 1, scr, r, lane); continue; } r -= I_GU;
            if (r < I_GU) { tr_item(f2u + fo, D, FF, norm_ffn2 + li * D, Wl + O_GU2, 2, scr, r, lane); continue; } r -= I_GU;
            if (r < I_DN) { tr_item(f2d + fo, FF, D, nullptr, Wl + O_D2, 0, scr, r, lane); continue; } r -= I_DN;
            if (r < I_IN) {
                if ((li & 1) == 0) tr_item(w_in_ab + (size_t)j * D * NAB, D, NAB, norm_mix + li * D, Wl + O_IN, 3, scr, r, lane);
                else if (r < I_INC) tr_item(w_in_c + (size_t)j * D * NC, D, NC, norm_mix + li * D, Wl + O_IN, 0, scr, r, lane);
                continue; } r -= I_IN;
            if (r < I_SQ) { tr_item(((li & 1) == 0 ? w_out_ab : w_out_c) + (size_t)j * D * D, D, D, nullptr, Wl + O_OUT, 0, scr, r, lane); continue; } r -= I_SQ;
            if (r < I_SQ) { tr_item(w_pg + (size_t)li * D * D, D, D, norm_ple + li * D, Wl + O_PG, 0, scr, r, lane); continue; } r -= I_SQ;
            tr_item(w_pp + (size_t)li * PLE * D, PLE, D, nullptr, Wl + O_PP, 0, scr, r, lane);
        }
    };
    auto rt_fill = [&](const u64* sqp, int tid) -> const LAS float* {
        if (!fastmap) return nullptr;
        LAS float* rt = (LAS float*)(lds + RT_OFF);
#pragma unroll
        for (int k = 0; k < 4; ++k) { const int t = tid + k * (NWAVES * 64); rt[t] = __builtin_amdgcn_rsqf((float)sqp[(size_t)(cvirt & 7) * 2048 + t] * (1.f / (1024.f * SSQ_FX)) + EPS); }
        __syncthreads();
        return rt;
    };
#define RT_FILL(p) rt_fill((p), tid)
    int pc = 0;
#define PHASE_BEGIN if (pc >= lo && pc < hi) { const int lane = lane_id_opaque(); const int tid = wave * 64 + lane; const int gtid = blockIdx.x * (NWAVES * 64) + tid; (void)gtid;
#define PHASE_END   if (pc + 1 < hi) { xcd_barrier(xbar, wave * 64 + lane_id_opaque()); } } ++pc;
#define PHASE_END_L if (pc + 1 < hi) { if (fastbar) xcc_local_barrier(xbar, wave * 64 + lane_id_opaque()); else { xcd_barrier(xbar, wave * 64 + lane_id_opaque()); if (MK_DBL & 1024) xcd_barrier(xbar, wave * 64 + lane_id_opaque()); } } } ++pc;

    PHASE_BEGIN
    for (int rep = 0; rep < ((MK_DBL & 1) ? 2 : 1); ++rep) {
        convert_items(gw, NGW, (MK_LATECONV ? 1 : DEPTH) * L_ITEMS, lane);
        for (int m = gw; m < T; m += NGW) {
            const f32x4* xr = (const f32x4*)(x + (size_t)m * D) + lane; f32x4* hr = (f32x4*)(h + (size_t)m * D) + lane; u32x2* br = (u32x2*)(hb + (size_t)m * D) + lane;
            float s = 0.f;
#pragma unroll
            for (int q = 0; q < 4; ++q) { const f32x4 v = xr[64 * q]; if (!MK_BF16RES) hr[64 * q] = v; u32x2 w; w.x = pk2(v[0], v[1]); w.y = pk2(v[2], v[3]); br[64 * q] = w;
                if (MK_BF16RES == 2) *(unsigned*)(hl8 + (size_t)m * D + lo8_pos(4 * (lane + 64 * q))) = lo8_enc(v[0], bflo(w.x)) | (lo8_enc(v[1], bfhi(w.x)) << 8) | (lo8_enc(v[2], bflo(w.y)) << 16) | (lo8_enc(v[3], bfhi(w.y)) << 24); s += (v[0] * v[0] + v[1] * v[1]) + (v[2] * v[2] + v[3] * v[3]); }
            s = wave_sum(s);
            if (lane == 0) ssq[m] = (u64)(s * SSQ_FX);
        }
        for (int i = gtid; i < 16 * T; i += NGT) ssq[T + i] = 0ull;
        {
        }
        for (int i0 = gtid; i0 < DEPTH * T * PLE / 8; i0 += 4 * NGT) {
            f32x4 a[4], c[4];
#pragma unroll
            for (int k = 0; k < 4; ++k) { const int i = i0 + k * NGT; if (i < DEPTH * T * PLE / 8) { a[k] = __builtin_nontemporal_load((const f32x4*)p_in + 2 * i); c[k] = __builtin_nontemporal_load((const f32x4*)p_in + 2 * i + 1); } }
#pragma unroll
            for (int k = 0; k < 4; ++k) { const int i = i0 + k * NGT; if (i < DEPTH * T * PLE / 8) {
                u32x4 w; w.x = pk2(a[k][0], a[k][1]); w.y = pk2(a[k][2], a[k][3]); w.z = pk2(c[k][0], c[k][1]); w.w = pk2(c[k][2], c[k][3]);
                ((u32x4*)pb)[i] = w; } }
        }
        for (int i = gtid; i < SEQ * 32; i += NGT) {
            const int pos = i >> 5, dd = i & 31;
            const float inv = exp2f(-(float)dd * (13.287712379549449f / 32.f));
            const float ang = (float)pos * inv;
            double rev = (double)ang * 0.15915494309189535; rev -= __builtin_rint(rev);
            const float rv = (float)rev;
            ctab[i] = __builtin_amdgcn_cosf(rv); stab[i] = __builtin_amdgcn_sinf(rv);
        }
    }
    PHASE_END
    if (lo == 0 && hi > 1) {
        if (wave == 0 && lane_id_opaque() == 0) {
            unsigned ok = gridDim.x == 256 && xbar.x < 8u;
            for (unsigned jx = 0; jx < 16; ++jx) { const unsigned cnt = xb_ld((unsigned*)ws + XB_XCNT(jx)); ok = ok && (cnt == (jx < 8 ? 32u : 0u)); }
            ((volatile LAS unsigned*)(lds + 131072))[9] = ok;
        }
        __syncthreads();
        fastmap = __builtin_amdgcn_readfirstlane((int)((volatile LAS unsigned*)(lds + 131072))[9]) != 0;
        if (fastmap) { cvirt = __builtin_amdgcn_readfirstlane((int)(((volatile LAS unsigned*)(lds + 131072))[8] * 8u + xbar.x)); gwa = ((cvirt & 7) * 32 + (cvirt >> 3)) * NWAVES + wave; }
    }

#pragma unroll 1
    for (int li = 0; li < DEPTH; ++li) {
        const bf16_t* Wl = Wb + (size_t)li * LAYER_W;
        const int j = li >> 1;
        u64* sq = ssq + (size_t)(4 * li) * T;
        PHASE_BEGIN
        for (int rep = 0; rep < ((MK_DBL & 4) ? 2 : 1); ++rep)
        { pg8::Gemm g{li == 0 ? hb : hb_alt, Wl + O_GU1, T, NGU, D}; pg8::StaticOrder S; S.init(T, NGU, G, cvirt);
          EpiGateUp E{act, sq, RT_FILL(sq)};
          pg8::gemm_phase<EpiGateUp, pg8::StaticOrder, true, true>(lds, g, S, E, tid); }
        if (MK_LATECONV && li + 1 < DEPTH) {
            const int ln = lane_id_opaque();
            if (G == 256) { if (cvirt >= 128) convert_items((li + 1) * L_ITEMS + (cvirt - 128) * NWAVES + wave, 128 * NWAVES, (li + 2) * L_ITEMS, ln); }
            else convert_items((li + 1) * L_ITEMS + gw, NGW, (li + 2) * L_ITEMS, ln);
        }
        PHASE_END_L
        PHASE_BEGIN
        if (MK_DBL & 64) { pg8::Gemm g{act, Wl + O_D1, T, D, FF}; pg8::StaticOrder S; S.init(T, D, G, cvirt); EpiRes<0> E{h, hb, hb, (u64*)obp, nullptr, nullptr, 0.0f, hl8}; pg8::gemm_phase<EpiRes<0>, pg8::StaticOrder, true, true>(lds, g, S, E, tid); }
        if (MK_DBL & 16) { pg8::Gemm g{act, Wl + O_D1, T, D, FF}; pg8::StaticOrder S; S.init(T, D, G, cvirt); EpiNull E{h, lo < 0}; pg8::gemm_phase<EpiNull, pg8::StaticOrder, false, true>(lds, g, S, E, tid); }
        { pg8::Gemm g{act, Wl + O_D1, T, D, FF}; pg8::StaticOrder S; S.init(T, D, G, cvirt);
          EpiRes<0> E{h, li == 0 ? hb : hb_alt, hb, sq + 1 * T, nullptr, nullptr, 0.5f, hl8};
          pg8::gemm_phase<EpiRes<0>, pg8::StaticOrder, true, true>(lds, g, S, E, tid); }
        PHASE_END
        if ((li & 1) == 0) {
            PHASE_BEGIN
            for (int rep = 0; rep < ((MK_DBL & 8) ? 2 : 1); ++rep)
            { pg8::Gemm g{hb, Wl + O_IN, T, NAB, D}; pg8::StaticOrder S; S.init(T, NAB, G, cvirt);
              EpiQKV<1> E{qk, vT, sq + 1 * T, ctab, stab, RT_FILL(sq + 1 * T)};
              pg8::gemm_phase<EpiQKV<1>, pg8::StaticOrder, true, true>(lds, g, S, E, tid); }
            PHASE_END
            PHASE_BEGIN
#if MK_NQ2
            for (int u2 = gwa; u2 < ((MK_DBL & 2) ? 2 : 1) * 6144; u2 += NGW) { const int unit = u2 >= 6144 ? u2 - 6144 : u2;
                if (unit < 3072) attn_a2_unit(unit, qk, vT, sink_a + j * 12, ao, lds + wave * WAVE_LDS, lane);
                else attn_b2_unit(unit - 3072, qk, vT, obp, lse, lds + wave * WAVE_LDS, lane);
            }
#else
            for (int u2 = gwa; u2 < ((MK_DBL & 2) ? 2 : 1) * 12288; u2 += NGW) { const int unit = u2 >= 12288 ? u2 - 12288 : u2;
                if (unit < 6144) attn_a_unit(unit, qk, vT, sink_a + j * 12, ao, lds + wave * WAVE_LDS, lane);
                else attn_b_unit(unit - 6144, qk, vT, obp, lse, lds + wave * WAVE_LDS, lane);
            }
#endif
            PHASE_END
            PHASE_BEGIN
            for (int i0 = gtid; i0 < T * 32; i0 += 2 * NGT) {
                const int iA = i0, iB = i0 + NGT; const bool hasB = iB < T * 32;
                const int rowA = iA >> 5, cA = (iA & 31) * 8, slA = cA >> 6, rowB = hasB ? iB >> 5 : rowA, cB = hasB ? (iB & 31) * 8 : cA, slB = cB >> 6;
                const float a0 = lse[(size_t)rowA * 4 + slA], a1 = lse[((size_t)T + rowA) * 4 + slA], a2 = lse[((size_t)2 * T + rowA) * 4 + slA];
                const float b0 = lse[(size_t)rowB * 4 + slB], b1 = lse[((size_t)T + rowB) * 4 + slB], b2 = lse[((size_t)2 * T + rowB) * 4 + slB];
                const u32x4 pa0 = *(const u32x4*)(obp + (size_t)rowA * 256 + cA), pa1 = *(const u32x4*)(obp + ((size_t)T + rowA) * 256 + cA), pa2 = *(const u32x4*)(obp + ((size_t)2 * T + rowA) * 256 + cA);
                const u32x4 pb0 = *(const u32x4*)(obp + (size_t)rowB * 256 + cB), pb1 = *(const u32x4*)(obp + ((size_t)T + rowB) * 256 + cB), pb2 = *(const u32x4*)(obp + ((size_t)2 * T + rowB) * 256 + cB);
                auto mrg = [&](float l0, float l1, float l2, const u32x4& a, const u32x4& bq, const u32x4& c, int row, int c8) {
                    const float mx = fmaxf(l0, fmaxf(l1, l2));
                    float w0 = fexp2(l0 - mx), w1 = fexp2(l1 - mx), w2 = fexp2(l2 - mx);
                    const float inv = 1.f / (w0 + w1 + w2); w0 *= inv; w1 *= inv; w2 *= inv;
                    u32x4 o;
                    o.x = pk2(w0 * bflo(a.x) + w1 * bflo(bq.x) + w2 * bflo(c.x), w0 * bfhi(a.x) + w1 * bfhi(bq.x) + w2 * bfhi(c.x));
                    o.y = pk2(w0 * bflo(a.y) + w1 * bflo(bq.y) + w2 * bflo(c.y), w0 * bfhi(a.y) + w1 * bfhi(bq.y) + w2 * bfhi(c.y));
                    o.z = pk2(w0 * bflo(a.z) + w1 * bflo(bq.z) + w2 * bflo(c.z), w0 * bfhi(a.z) + w1 * bfhi(bq.z) + w2 * bfhi(c.z));
                    o.w = pk2(w0 * bflo(a.w) + w1 * bflo(bq.w) + w2 * bflo(c.w), w0 * bfhi(a.w) + w1 * bfhi(bq.w) + w2 * bfhi(c.w));
                    *(u32x4*)(ao + (size_t)row * D + 768 + c8) = o; };
                mrg(a0, a1, a2, pa0, pa1, pa2, rowA, cA);
                if (hasB) mrg(b0, b1, b2, pb0, pb1, pb2, rowB, cB);
            }
            PHASE_END
        } else {
            PHASE_BEGIN
            for (int rep = 0; rep < ((MK_DBL & 8) ? 2 : 1); ++rep)
            { pg8::Gemm g{hb, Wl + O_IN, T, NC, D}; pg8::StaticOrder S; S.init(T, NC, G, cvirt);
              EpiQKV<0> E{qk, vT, sq + 1 * T, ctab, stab, RT_FILL(sq + 1 * T)};
              pg8::gemm_phase<EpiQKV<0>, pg8::StaticOrder, true, true>(lds, g, S, E, tid); }
            PHASE_END
            PHASE_BEGIN
            {
              int cur_h = -1;
              for (int u2 = gwa; u2 < ((MK_DBL & 2) ? 2 : 1) * 8192; u2 += NGW)
                  attn_c_unit((u2 & 127) | (((u2 >> 11) & 3) << 7) | (((u2 >> 7) & 15) << 9), cur_h, qk, vT, rpb_c + (size_t)j * 16 * 465, ao, lds + wave * WAVE_LDS, lane); }
            PHASE_END
        }
        PHASE_BEGIN
        if (MK_DBL & 32) { pg8::Gemm g{ao, Wl + O_OUT, T, D, D}; pg8::StaticOrder S; S.init(T, D, G, cvirt); EpiNull E{h, lo < 0}; pg8::gemm_phase<EpiNull, pg8::StaticOrder, false, true>(lds, g, S, E, tid); }
        { pg8::Gemm g{ao, Wl + O_OUT, T, D, D}; pg8::StaticOrder S; S.init(T, D, G, cvirt);
          EpiRes<0> E{h, hb, hb, sq + 2 * T, nullptr, nullptr, 1.0f, hl8};
          pg8::gemm_phase<EpiRes<0>, pg8::StaticOrder, true, true>(lds, g, S, E, tid); }
        PHASE_END_L
        PHASE_BEGIN
        for (int rep = 0; rep < ((MK_DBL & 4) ? 2 : 1); ++rep)
        { pg8::Gemm g{hb, Wl + O_GU2, T, NGU, D}; pg8::StaticOrder S; S.init(T, NGU, G, cvirt);
          EpiGateUp E{act, sq + 2 * T, RT_FILL(sq + 2 * T)};
          pg8::gemm_phase<EpiGateUp, pg8::StaticOrder, true, true>(lds, g, S, E, tid); }
        { pg8::Gemm g{pb + (size_t)li * T * PLE, Wl + O_PP, T, D, PLE}; PPOrder S{cvirt, G, 256};
          EpiPlain E{ppb};
          pg8::gemm_phase<EpiPlain, PPOrder, true, true>(lds, g, S, E, tid); }
        PHASE_END_L
        PHASE_BEGIN
        if (MK_DBL & 64) { pg8::Gemm g{act, Wl + O_D2, T, D, FF}; pg8::StaticOrder S; S.init(T, D, G, cvirt); EpiRes<0> E{h, hb, hb, (u64*)obp, nullptr, nullptr, 0.0f, hl8}; pg8::gemm_phase<EpiRes<0>, pg8::StaticOrder, true, true>(lds, g, S, E, tid); }
        if (MK_DBL & 16) { pg8::Gemm g{act, Wl + O_D2, T, D, FF}; pg8::StaticOrder S; S.init(T, D, G, cvirt); EpiNull E{h, lo < 0}; pg8::gemm_phase<EpiNull, pg8::StaticOrder, false, true>(lds, g, S, E, tid); }
        { pg8::Gemm g{act, Wl + O_D2, T, D, FF}; pg8::StaticOrder S; S.init(T, D, G, cvirt);
          EpiRes<0> E{h, hb, hb, sq + 3 * T, nullptr, nullptr, 0.5f, hl8};
          pg8::gemm_phase<EpiRes<0>, pg8::StaticOrder, true, true>(lds, g, S, E, tid); }
        PHASE_END_L
        PHASE_BEGIN
        if (MK_DBL & 32) { pg8::Gemm g{hb, Wl + O_PG, T, D, D}; pg8::StaticOrder S; S.init(T, D, G, cvirt); EpiNull E{h, lo < 0}; pg8::gemm_phase<EpiNull, pg8::StaticOrder, false, true>(lds, g, S, E, tid); }
        { pg8::Gemm g{hb, Wl + O_PG, T, D, D}; pg8::StaticOrder S; S.init(T, D, G, cvirt);
          EpiRes<1> E{h, hb, hb_alt, sq + 4 * T, sq + 3 * T, ppb, 1.0f, hl8};
          pg8::gemm_phase<EpiRes<1>, pg8::StaticOrder, true, true>(lds, g, S, E, tid); }
        if (pc + 1 < hi) { if (fastbar && li + 1 < DEPTH) xcc_local_barrier(xbar, wave * 64 + lane_id_opaque()); else xcd_barrier(xbar, wave * 64 + lane_id_opaque()); } } ++pc;
    }
    PHASE_BEGIN
    {
        const u64* sq = ssq + (size_t)16 * T;
        for (int i0 = gtid; i0 < T * D / 4; i0 += 4 * NGT) {
            u32x2 q[4]; unsigned ql[4]; u64 sv[4];
#pragma unroll
            for (int k = 0; k < 4; ++k) { const int i = i0 + k * NGT; if (i < T * D / 4) { q[k] = ((const u32x2*)hb_alt)[i]; ql[k] = *(const unsigned*)(hl8 + (size_t)(i >> 8) * D + lo8_pos((i & 255) * 4)); sv[k] = sq[i >> 8]; } }
#pragma unroll
            for (int k = 0; k < 4; ++k) { const int i = i0 + k * NGT; if (i < T * D / 4) {
                const int c4 = (i & 255) * 4;
                const float r = __builtin_amdgcn_rsqf((float)sv[k] * (1.f / (1024.f * SSQ_FX)) + EPS);
                f32x4 v = {lo8_dec(bflo(q[k].x), sb(ql[k], 0)), lo8_dec(bfhi(q[k].x), sb(ql[k], 1)), lo8_dec(bflo(q[k].y), sb(ql[k], 2)), lo8_dec(bfhi(q[k].y), sb(ql[k], 3))};
                const f32x4 gg = *(const f32x4*)(norm_final + c4);
                v = v * r * gg; __builtin_nontemporal_store(v, (f32x4*)h + i); } }
        }
    }
    PHASE_END
#undef PHASE_BEGIN
#undef PHASE_END
#undef PHASE_END_L
}

constexpr int N_PHASES = 1 + 9 + 8 + 9 + 8 + 1;

extern "C" void kernel_launch(void* const* d_in, const int* in_sizes, int n_in, void* d_out, int out_size, void* d_ws, size_t ws_size, hipStream_t stream) {
    static int grid = 0;
    if (grid == 0) {
        if (n_in != 21 || out_size != T * D || ws_size < WS_END) { fprintf(stderr, "kernel_launch: unexpected shapes (n_in %d out %d ws %zu)\n", n_in, out_size, ws_size); grid = -1; return; }
        int dev = 0, cus = 0, per_cu = 0;
        hipGetDevice(&dev); hipDeviceGetAttribute(&cus, hipDeviceAttributeMultiprocessorCount, dev);
        hipFuncSetAttribute((const void*)mk_fwd, hipFuncAttributeMaxDynamicSharedMemorySize, LDS_BYTES);
        hipOccupancyMaxActiveBlocksPerMultiprocessor(&per_cu, (const void*)mk_fwd, NWAVES * 64, LDS_BYTES);
        if (per_cu < 1) { fprintf(stderr, "kernel_launch: occupancy query says %d blocks per CU\n", per_cu); per_cu = 1; }
        (void)hipGetLastError();
        grid = cus * per_cu;
    }
    if (grid < 0) return;
#if !MK_COOP
    if (hipMemsetAsync(d_ws, 0, 32768, stream) != hipSuccess) { fprintf(stderr, "kernel_launch: memset failed\n"); return; }
#endif
    Args a{};
    for (int i = 0; i < 21; ++i) a.in[i] = (const float*)d_in[i];
    a.out = (float*)d_out; a.ws = (unsigned char*)d_ws;
#if MK_COOP
    a.ph_lo = 0; a.ph_hi = N_PHASES;
    void* kargs[] = {&a};
    hipError_t e = hipLaunchCooperativeKernel((const void*)mk_fwd, dim3(grid), dim3(NWAVES * 64), kargs, LDS_BYTES, stream);
    if (e != hipSuccess) fprintf(stderr, "cooperative launch failed: %s (grid %d)\n", hipGetErrorString(e), grid);
#else
    for (int p = 0; p < N_PHASES; ++p) {
        a.ph_lo = p; a.ph_hi = p + 1;
        hipLaunchKernelGGL(mk_fwd, dim3(grid), dim3(NWAVES * 64), LDS_BYTES, stream, a);
    }
#endif
}
```
